# Optimizing an MI355X kernel written in HIP

```python
import math
import jax, jax.numpy as jnp
from jax import lax
import numpy as np

D_MODEL = 2048
BATCH = 2
SEQ = 4096
DEPTH = 4

N_MIXERS = 2
N_FOX_LAYERS = (DEPTH + 1) // 2
N_RET_LAYERS = DEPTH // 2

FOX_HEAD_DIM = 128
FOX_HEADS = D_MODEL // FOX_HEAD_DIM
FOX_WIDTH = FOX_HEADS * FOX_HEAD_DIM
FOX_BLOCK = 128
FOX_IN_COLS = 4 * FOX_WIDTH + FOX_HEADS

RET_QK_DIM = 256
RET_HEADS = D_MODEL // RET_QK_DIM
RET_V_DIM = 2 * RET_QK_DIM
RET_QK_WIDTH = RET_HEADS * RET_QK_DIM
RET_V_WIDTH = RET_HEADS * RET_V_DIM
RET_CHUNK = 128
RET_IN_COLS = 2 * RET_QK_WIDTH + 2 * RET_V_WIDTH
ROPE_BASE = 10000.0

LN_EPS = 1e-5
GN_EPS = 1e-6
QK_EPS = 1e-6
DEEPNORM_ALPHA = (2.0 * DEPTH) ** 0.25
DEEPNORM_BETA = (8.0 * DEPTH) ** -0.25

kernel_name = "fox_retnet_interleaved_deepnorm"


def layer_norm(x, g, b):
    xf = x.astype(jnp.float32)
    mu = jnp.mean(xf, axis=-1, keepdims=True)
    var = jnp.mean(jnp.square(xf - mu), axis=-1, keepdims=True)
    y = (xf - mu) * lax.rsqrt(var + LN_EPS) * g.astype(jnp.float32) + b.astype(jnp.float32)
    return y.astype(x.dtype)


def rms_norm(x, g):
    xf = x.astype(jnp.float32)
    y = xf * lax.rsqrt(jnp.mean(jnp.square(xf), axis=-1, keepdims=True) + QK_EPS) * g.astype(jnp.float32)
    return y.astype(x.dtype)


def group_norm_heads(x):
    mu = jnp.mean(x, axis=-1, keepdims=True)
    var = jnp.mean(jnp.square(x - mu), axis=-1, keepdims=True)
    return (x - mu) * lax.rsqrt(var + GN_EPS)


def rotary(t):
    S, d = t.shape[1], t.shape[-1]
    inv_freq = ROPE_BASE ** (-jnp.arange(0, d, 2, dtype=jnp.float32) / d)
    ang = jnp.arange(S, dtype=jnp.float32)[:, None] * inv_freq[None, :]
    cos = jnp.cos(ang)[None, :, None, :]
    sin = jnp.sin(ang)[None, :, None, :]
    t1, t2 = t[..., : d // 2], t[..., d // 2:]
    return jnp.concatenate([t1 * cos - t2 * sin, t1 * sin + t2 * cos], axis=-1)


def fox_branch(x, w_in, b_f, q_gain, k_gain, w_out):
    B, S, _ = x.shape
    proj = jnp.einsum('bsd,de->bse', x, w_in)
    q, k, v, gate, f_logit = jnp.split(
        proj, [FOX_WIDTH, 2 * FOX_WIDTH, 3 * FOX_WIDTH, 4 * FOX_WIDTH], axis=-1)

    def heads(t):
        return t.reshape(B, S, FOX_HEADS, FOX_HEAD_DIM).transpose(0, 2, 1, 3)

    q = rms_norm(heads(q), q_gain)
    k = rms_norm(heads(k), k_gain)
    v = heads(v)
    log_f = jax.nn.log_sigmoid((f_logit + b_f).astype(jnp.float32))
    c = jnp.cumsum(log_f, axis=1).transpose(0, 2, 1)

    n_blocks = S // FOX_BLOCK
    q_blocks = q.reshape(B, FOX_HEADS, n_blocks, FOX_BLOCK, FOX_HEAD_DIM).transpose(2, 0, 1, 3, 4)
    c_blocks = c.reshape(B, FOX_HEADS, n_blocks, FOX_BLOCK).transpose(2, 0, 1, 3)
    key_pos = jnp.arange(S)
    scale = FOX_HEAD_DIM ** -0.5

    def attend_block(args):
        qb, cb, blk = args
        s = jnp.einsum('bhqd,bhkd->bhqk', qb, k).astype(jnp.float32) * scale
        s = s + cb[..., :, None] - c[..., None, :]
        q_pos = blk * FOX_BLOCK + jnp.arange(FOX_BLOCK)
        s = jnp.where(key_pos[None, :] <= q_pos[:, None], s, -jnp.inf)
        p = jax.nn.softmax(s, axis=-1).astype(v.dtype)
        return jnp.einsum('bhqk,bhkd->bhqd', p, v)

    o = lax.map(attend_block, (q_blocks, c_blocks, jnp.arange(n_blocks)))
    o = o.transpose(1, 0, 3, 2, 4).reshape(B, S, FOX_WIDTH)
    y = o * jax.nn.silu(gate)
    return jnp.einsum('bse,ed->bsd', y, w_out)


def retention_branch(x, w_in, w_out):
    B, S, _ = x.shape
    proj = jnp.einsum('bsd,de->bse', x, w_in)
    q, k, v, gate = jnp.split(
        proj, [RET_QK_WIDTH, 2 * RET_QK_WIDTH, 2 * RET_QK_WIDTH + RET_V_WIDTH], axis=-1)
    q = rotary(q.reshape(B, S, RET_HEADS, RET_QK_DIM).astype(jnp.float32))
    k = rotary(k.reshape(B, S, RET_HEADS, RET_QK_DIM).astype(jnp.float32)) * (RET_QK_DIM ** -0.5)
    v = v.reshape(B, S, RET_HEADS, RET_V_DIM).astype(jnp.float32)

    log_gamma = jnp.log1p(-jnp.exp2(-5.0 - jnp.arange(RET_HEADS, dtype=jnp.float32)))
    pos = jnp.arange(RET_CHUNK, dtype=jnp.float32)
    diff = pos[:, None] - pos[None, :]
    intra_decay = jnp.where(diff >= 0,
                            jnp.exp(jnp.maximum(diff, 0.0)[None] * log_gamma[:, None, None]),
                            0.0)
    query_decay = jnp.exp((pos[None, :] + 1.0) * log_gamma[:, None])
    key_decay = jnp.exp((RET_CHUNK - 1.0 - pos[None, :]) * log_gamma[:, None])
    chunk_decay = jnp.exp(RET_CHUNK * log_gamma)

    n_chunks = S // RET_CHUNK

    def chunks(t):
        return t.reshape(B, n_chunks, RET_CHUNK, RET_HEADS, t.shape[-1]).transpose(1, 0, 3, 2, 4)

    def step(R, inp):
        qc, kc, vc = inp
        inner = jnp.einsum('bhqd,bhkd->bhqk', qc, kc) * intra_decay[None]
        o = (jnp.einsum('bhqk,bhkv->bhqv', inner, vc)
             + jnp.einsum('bhqd,bhdv->bhqv', qc, R) * query_decay[None, :, :, None])
        R = (R * chunk_decay[None, :, None, None]
             + jnp.einsum('bhkd,bhkv->bhdv', kc * key_decay[None, :, :, None], vc))
        return R, o

    R0 = jnp.zeros((B, RET_HEADS, RET_QK_DIM, RET_V_DIM), jnp.float32)
    _, o = lax.scan(step, R0, (chunks(q), chunks(k), chunks(v)))
    o = o.transpose(1, 0, 3, 2, 4)
    o = group_norm_heads(o).reshape(B, S, RET_V_WIDTH).astype(gate.dtype)
    y = o * jax.nn.silu(gate)
    return jnp.einsum('bse,ed->bsd', y, w_out)


def setup_inputs(seed: int = 0) -> dict:
    key = jax.random.key(seed)
    ks = jax.random.split(key, 10)
    std_in = D_MODEL ** -0.5
    fox_col_scale = jnp.ones((FOX_IN_COLS,), jnp.float32).at[2 * FOX_WIDTH:3 * FOX_WIDTH].set(DEEPNORM_BETA)
    ret_col_scale = jnp.ones((RET_IN_COLS,), jnp.float32).at[
        2 * RET_QK_WIDTH:2 * RET_QK_WIDTH + RET_V_WIDTH].set(DEEPNORM_BETA)
    x = jax.random.normal(ks[0], (BATCH, SEQ, D_MODEL), jnp.float32)
    fox_w_in = jax.random.normal(ks[1], (N_FOX_LAYERS, D_MODEL, FOX_IN_COLS), jnp.float32) * std_in * fox_col_scale
    fox_b_f = 3.0 + 0.5 * jax.random.normal(ks[2], (N_FOX_LAYERS, FOX_HEADS), jnp.float32)
    fox_q_gain = 1.0 + 0.02 * jax.random.normal(ks[3], (N_FOX_LAYERS, FOX_HEAD_DIM), jnp.float32)
    fox_k_gain = 1.0 + 0.02 * jax.random.normal(ks[4], (N_FOX_LAYERS, FOX_HEAD_DIM), jnp.float32)
    fox_w_out = (jax.random.normal(ks[5], (N_FOX_LAYERS, FOX_WIDTH, D_MODEL), jnp.float32)
                 * (FOX_WIDTH ** -0.5) * DEEPNORM_BETA)
    ret_w_in = jax.random.normal(ks[6], (N_RET_LAYERS, D_MODEL, RET_IN_COLS), jnp.float32) * std_in * ret_col_scale
    ret_w_out = (jax.random.normal(ks[7], (N_RET_LAYERS, RET_V_WIDTH, D_MODEL), jnp.float32)
                 * (RET_V_WIDTH ** -0.5) * DEEPNORM_BETA)
    ln_gain = 1.0 + 0.02 * jax.random.normal(ks[8], (DEPTH, D_MODEL), jnp.float32)
    ln_bias = 0.02 * jax.random.normal(ks[9], (DEPTH, D_MODEL), jnp.float32)
    return {"x": x, "fox_w_in": fox_w_in, "fox_b_f": fox_b_f, "fox_q_gain": fox_q_gain,
            "fox_k_gain": fox_k_gain, "fox_w_out": fox_w_out, "ret_w_in": ret_w_in,
            "ret_w_out": ret_w_out, "ln_gain": ln_gain, "ln_bias": ln_bias}


def reference(x, fox_w_in, fox_b_f, fox_q_gain, fox_k_gain, fox_w_out, ret_w_in, ret_w_out,
              ln_gain, ln_bias):
    h = x
    for i in range(DEPTH):
        j = i // N_MIXERS
        if i % N_MIXERS == 0:
            y = fox_branch(h, fox_w_in[j], fox_b_f[j], fox_q_gain[j], fox_k_gain[j], fox_w_out[j])
        else:
            y = retention_branch(h, ret_w_in[j], ret_w_out[j])
        h = layer_norm(DEEPNORM_ALPHA * h + y, ln_gain[i], ln_bias[i])
    return h
```

```cpp
#include <hip/hip_runtime.h>
#include <hip/hip_cooperative_groups.h>
#include <cstdio>
#include <cstdint>
namespace cg = cooperative_groups;
#ifndef RESID_BF16
#define RESID_BF16 1
#endif

#define DI __device__ __forceinline__
typedef unsigned short bf16;
typedef short bf16x8 __attribute__((ext_vector_type(8)));
typedef short s16x4 __attribute__((ext_vector_type(4)));
typedef float f32x4 __attribute__((ext_vector_type(4)));
typedef float f32x16 __attribute__((ext_vector_type(16)));
typedef unsigned u32x4 __attribute__((ext_vector_type(4)));
typedef unsigned u32x2 __attribute__((ext_vector_type(2)));

DI unsigned cvt_pk_bf16(float lo, float hi) { unsigned r; asm volatile("v_cvt_pk_bf16_f32 %0, %1, %2" : "=v"(r) : "v"(lo), "v"(hi)); return r; }
DI float bf_lo(unsigned w) { return __uint_as_float(w << 16); }
DI float bf_hi(unsigned w) { return __uint_as_float(w & 0xffff0000u); }
DI float bf2f(bf16 b) { return __uint_as_float(((unsigned)b) << 16); }
DI unsigned f2bf(float f) { unsigned u = __float_as_uint(f); return (u + 0x7fffu + ((u >> 16) & 1u)) >> 16; }
DI float wave_sum(float v) {
#pragma unroll
    for (int o = 1; o < 64; o <<= 1) v += __shfl_xor(v, o);
    return v;
}

namespace pg8 {
#define PG8_LAS __attribute__((address_space(3)))
constexpr int BM = 256, BK = 64, HALF = 128, HTB = HALF * BK * 2, STAGE_BYTES = 8 * HTB, NXCD = 8, WGM = 8;
DI int lds_byte(int r, int c) { const int st = (r >> 4) * 2 + (c >> 5), rr = r & 15, cc = c & 31, ob = rr * 64 + cc * 2; return st * 1024 + (ob ^ (((ob >> 9) & 1) << 5)); }
DI void stage_rc(int b, int& R, int& C) { const int st = b / 1024, sb = b % 1024, swz = sb ^ (((sb >> 9) & 1) << 5); R = (st >> 1) * 16 + swz / 64; C = (st & 1) * 32 + (swz % 64) / 2; }
DI int perm32(int rho) { const int n = rho >> 4, i = rho & 15; return 8 * (i >> 2) + 4 * n + (i & 3); }

struct Unit { int pm, pn; unsigned aoff, boff; };
struct Gemm { const bf16* A; const bf16* Bt; int lda, ldb, K; };

struct Sched {
    int mode;
    int nM, nN, nwg, G, c;
    int bsplit, bskip;
    unsigned atile, btile;
    int nj; unsigned ab, aj, bb, bj;
    DI void init_reg(int nM_, int nN_, int lda, int ldb, int G_, int c_, int bsplit_ = 1 << 30, int bskip_ = 0) {
        mode = 0; nM = nM_; nN = nN_; nwg = nM * nN; G = G_; c = c_; bsplit = bsplit_; bskip = bskip_; atile = 256u * lda * 2u; btile = 256u * ldb * 2u; nj = 1; ab = aj = bb = bj = 0; }
    DI void init_bat(int nbatch, int nj_, unsigned ab_, unsigned aj_, unsigned bb_, unsigned bj_, int G_, int c_) {
        mode = 1; nM = nbatch; nN = nj_; nwg = nbatch * nj_; G = G_; c = c_; bsplit = 1 << 30; bskip = 0; atile = btile = 0; nj = nj_; ab = ab_; aj = aj_; bb = bb_; bj = bj_; }
    DI bool next(int i, Unit& u) const {
        const int L = i * G + c; if (L >= nwg) return false;
        if (mode == 0) {
            int wgid = L; { const int q = nwg / NXCD, r = nwg % NXCD, xcd = wgid % NXCD, off = wgid / NXCD; wgid = (xcd < r ? xcd * (q + 1) : r * (q + 1) + (xcd - r) * q) + off; }
            const int nig = WGM * nN, gid = wgid / nig, fm = gid * WGM, gsz = (nM - fm) < WGM ? (nM - fm) : WGM;
            u.pm = fm + ((wgid % nig) % gsz); u.pn = (wgid % nig) / gsz;
            const int pb = u.pn < bsplit ? u.pn : u.pn + bskip;
            u.aoff = (unsigned)u.pm * atile; u.boff = (unsigned)pb * btile;
        } else {
            int batch, j;
            if (nj == 2) { const int g16 = L >> 4, r16 = L & 15; j = r16 >> 3; batch = g16 * 8 + (r16 & 7); }
            else { batch = L / nj; j = L - batch * nj; }
            u.pm = batch; u.pn = j;
            u.aoff = (unsigned)batch * ab + (unsigned)j * aj; u.boff = (unsigned)batch * bb + (unsigned)j * bj;
        }
        return true;
    }
};

DI u32x4 pack8(const f32x4& v0, const f32x4& v1) { u32x4 w; w.x = cvt_pk_bf16(v0[0], v0[1]); w.y = cvt_pk_bf16(v0[2], v0[3]); w.z = cvt_pk_bf16(v1[0], v1[1]); w.w = cvt_pk_bf16(v1[2], v1[3]); return w; }

struct EpiBf16 {
    static constexpr bool PERM = true;
    bf16* O; int ldc;
    DI void operator()(const f32x4 (&acc)[2][2][4][2], const Unit& u, int wr, int wc, int fr, int fq) const {
        const int row0 = u.pm * BM + wr * 64 + fr, col0 = u.pn * BM + wc * 32 + 8 * fq;
#pragma unroll
        for (int ai = 0; ai < 2; ++ai)
#pragma unroll
            for (int m = 0; m < 4; ++m) { int rr = row0 + ai * HALF + m * 16; asm volatile("" : "+v"(rr)); bf16* rowp = O + (size_t)rr * ldc + col0;
#pragma unroll
                for (int bj = 0; bj < 2; ++bj) *(u32x4*)(rowp + bj * HALF) = pack8(acc[ai][bj][m][0], acc[ai][bj][m][1]); }
    }
};
struct EpiResid {
    static constexpr bool PERM = false;
    const float* resid; float* out; int ldc; float alpha;
    DI void operator()(const f32x4 (&acc)[2][2][4][2], const Unit& u, int wr, int wc, int fr, int fq) const {
        const int row0 = u.pm * BM + wr * 64 + fr, col0 = u.pn * BM + wc * 32 + 4 * fq;
#pragma unroll
        for (int ai = 0; ai < 2; ++ai)
#pragma unroll
            for (int m = 0; m < 4; ++m) { int rr = row0 + ai * HALF + m * 16; asm volatile("" : "+v"(rr)); const size_t off = (size_t)rr * ldc + col0;
#pragma unroll
                for (int bj = 0; bj < 2; ++bj)
#pragma unroll
                    for (int n = 0; n < 2; ++n) { const f32x4 rs = *(const f32x4*)(resid + off + bj * HALF + n * 16); *(f32x4*)(out + off + bj * HALF + n * 16) = rs * alpha + acc[ai][bj][m][n]; } }
    }
};
struct EpiLnFused {
    static constexpr bool PERM = false;
    const float* resid; float* outf; bf16* outb; const float* gn; const float* bt; float alpha;
    unsigned long long* xslots; unsigned* cnt; PG8_LAS unsigned char* xl;
    DI void operator()(f32x4 (&acc)[2][2][4][2], const Unit& u, int wr, int wc, int fr, int fq) const {
        const int row0 = u.pm * BM + wr * 64 + fr, col0 = u.pn * BM + wc * 32 + 4 * fq;
        const int tid = (wr * 4 + wc) * 64 + fq * 16 + fr;
        PG8_LAS float* P = (PG8_LAS float*)xl;
        PG8_LAS float* S = (PG8_LAS float*)(xl + 8192);
        f32x4 rsb[2][2][2];
#define RLOAD(g_, sl_) do { int rr_ = row0 + ((g_) >> 2) * HALF + ((g_) & 3) * 16; asm volatile("" : "+v"(rr_)); const size_t off_ = (size_t)rr_ * 2048 + col0; \
            _Pragma("unroll") for (int bj_ = 0; bj_ < 2; ++bj_) _Pragma("unroll") for (int n_ = 0; n_ < 2; ++n_) { \
                if (resid) rsb[sl_][bj_][n_] = *(const f32x4*)(resid + off_ + bj_ * HALF + n_ * 16); \
                else { const u32x2 rb_ = *(const u32x2*)(outb + off_ + bj_ * HALF + n_ * 16); rsb[sl_][bj_][n_] = (f32x4){bf_lo(rb_.x), bf_hi(rb_.x), bf_lo(rb_.y), bf_hi(rb_.y)}; } } } while (0)
        RLOAD(0, 0);
#pragma unroll
        for (int ai = 0; ai < 2; ++ai)
#pragma unroll
            for (int m = 0; m < 4; ++m) { const int gi = ai * 4 + m, sl = gi & 1;
                if (gi < 7) RLOAD(gi + 1, (gi + 1) & 1);
                int rr = row0 + ai * HALF + m * 16; asm volatile("" : "+v"(rr));
                float sm = 0.f, sq = 0.f;
#pragma unroll
                for (int bj = 0; bj < 2; ++bj)
#pragma unroll
                    for (int n = 0; n < 2; ++n) { const f32x4 t = rsb[sl][bj][n] * alpha + acc[ai][bj][m][n]; acc[ai][bj][m][n] = t;
                        sm += (t[0] + t[1]) + (t[2] + t[3]); sq += (t[0] * t[0] + t[1] * t[1]) + (t[2] * t[2] + t[3] * t[3]); }
                sm += __shfl_xor(sm, 16); sm += __shfl_xor(sm, 32); sq += __shfl_xor(sq, 16); sq += __shfl_xor(sq, 32);
                if (fq == 0) { const int rl = (rr - u.pm * BM); P[(rl * 4 + wc) * 2] = sm; P[(rl * 4 + wc) * 2 + 1] = sq; }
                asm volatile("" ::: "memory"); }
#undef RLOAD
        __syncthreads();
        if (tid < 256) { float sm = 0.f, sq = 0.f;
#pragma unroll
            for (int w = 0; w < 4; ++w) { sm += P[(tid * 4 + w) * 2]; sq += P[(tid * 4 + w) * 2 + 1]; }
            const unsigned long long v = ((unsigned long long)__float_as_uint(sq) << 32) | (unsigned long long)__float_as_uint(sm);
            __hip_atomic_store(xslots + ((size_t)(u.pm * 256 + tid) * 8 + u.pn), v, __ATOMIC_RELAXED, __HIP_MEMORY_SCOPE_AGENT); }
        asm volatile("s_waitcnt vmcnt(0)" ::: "memory");
        __syncthreads();
        if (tid == 0) { unsigned* cp = cnt + 64 * u.pm; __hip_atomic_fetch_add(cp, 1u, __ATOMIC_RELAXED, __HIP_MEMORY_SCOPE_AGENT);
            unsigned sp = 0; while (__hip_atomic_load(cp, __ATOMIC_RELAXED, __HIP_MEMORY_SCOPE_AGENT) < 8u) { __builtin_amdgcn_s_sleep(1); if (++sp > (1u << 22)) break; } }
        __syncthreads();
        if (tid < 256) { float sm = 0.f, sq = 0.f;
#pragma unroll
            for (int w = 0; w < 8; ++w) { const unsigned long long v = __hip_atomic_load(xslots + ((size_t)(u.pm * 256 + tid) * 8 + w), __ATOMIC_RELAXED, __HIP_MEMORY_SCOPE_AGENT);
                sm += __uint_as_float((unsigned)v); sq += __uint_as_float((unsigned)(v >> 32)); }
            const float mean = sm * (1.f / 2048.f); const float var = fmaxf(sq * (1.f / 2048.f) - mean * mean, 0.f);
            S[tid * 2] = mean; S[tid * 2 + 1] = rsqrtf(var + 1e-5f); }
        f32x4 g4[2][2], b4[2][2];
#pragma unroll
        for (int bj = 0; bj < 2; ++bj)
#pragma unroll
            for (int n = 0; n < 2; ++n) { g4[bj][n] = *(const f32x4*)(gn + col0 + bj * HALF + n * 16); b4[bj][n] = *(const f32x4*)(bt + col0 + bj * HALF + n * 16); }
        __syncthreads();
#pragma unroll
        for (int ai = 0; ai < 2; ++ai)
#pragma unroll
            for (int m = 0; m < 4; ++m) { int rr = row0 + ai * HALF + m * 16; asm volatile("" : "+v"(rr)); const size_t off = (size_t)rr * 2048 + col0;
                const int rl = rr - u.pm * BM; const float mean = S[rl * 2], rstd = S[rl * 2 + 1];
#pragma unroll
                for (int bj = 0; bj < 2; ++bj)
#pragma unroll
                    for (int n = 0; n < 2; ++n) { const f32x4 y = (acc[ai][bj][m][n] - mean) * rstd * g4[bj][n] + b4[bj][n];
                        if (outf) *(f32x4*)(outf + off + bj * HALF + n * 16) = y; if (!outf || !RESID_BF16) { u32x2 o; o.x = cvt_pk_bf16(y[0], y[1]); o.y = cvt_pk_bf16(y[2], y[3]); *(u32x2*)(outb + off + bj * HALF + n * 16) = o; } }
                asm volatile("" ::: "memory"); }
    }
};
struct EpiOGn {
    static constexpr bool PERM = true;
    bf16* Y; const bf16* GATE; unsigned long long* xslots; unsigned* cnt; PG8_LAS unsigned char* xl;
    DI void operator()(f32x4 (&acc)[2][2][4][2], const Unit& u, int wr, int wc, int fr, int fq) const {
        const int batch = u.pm, b = batch >> 7, hh = (batch >> 4) & 7, n = batch & 15;
        const int tid = (wr * 4 + wc) * 64 + fq * 16 + fr;
        PG8_LAS float* P = (PG8_LAS float*)xl; PG8_LAS float* S = (PG8_LAS float*)(xl + 8192);
        u32x4 gpl[2][2];
#define GLOADG(g_, sl_) do { int rl_ = ((g_) >> 2) * HALF + wr * 64 + ((g_) & 3) * 16 + fr; asm volatile("" : "+v"(rl_)); \
            const size_t off_ = ((size_t)b * 4096 + n * 256 + rl_) * 4096 + hh * 512 + u.pn * 256 + wc * 32 + 8 * fq; \
            gpl[sl_][0] = *(const u32x4*)(GATE + off_); gpl[sl_][1] = *(const u32x4*)(GATE + off_ + HALF); } while (0)
        GLOADG(0, 0);
#pragma unroll
        for (int ai = 0; ai < 2; ++ai)
#pragma unroll
            for (int m = 0; m < 4; ++m) { float sm = 0.f, sq = 0.f;
#pragma unroll
                for (int bj = 0; bj < 2; ++bj)
#pragma unroll
                    for (int n2 = 0; n2 < 2; ++n2) { const f32x4 t = acc[ai][bj][m][n2]; sm += (t[0] + t[1]) + (t[2] + t[3]); sq += (t[0] * t[0] + t[1] * t[1]) + (t[2] * t[2] + t[3] * t[3]); }
                sm += __shfl_xor(sm, 16); sm += __shfl_xor(sm, 32); sq += __shfl_xor(sq, 16); sq += __shfl_xor(sq, 32);
                if (fq == 0) { const int rl = ai * HALF + wr * 64 + m * 16 + fr; P[(rl * 4 + wc) * 2] = sm; P[(rl * 4 + wc) * 2 + 1] = sq; } }
        __syncthreads();
        if (tid < 256) { float sm = 0.f, sq = 0.f;
#pragma unroll
            for (int w = 0; w < 4; ++w) { sm += P[(tid * 4 + w) * 2]; sq += P[(tid * 4 + w) * 2 + 1]; }
            const unsigned long long v = ((unsigned long long)__float_as_uint(sq) << 32) | (unsigned long long)__float_as_uint(sm);
            __hip_atomic_store(xslots + ((size_t)(batch * 256 + tid) * 2 + u.pn), v, __ATOMIC_RELAXED, __HIP_MEMORY_SCOPE_AGENT); }
        asm volatile("s_waitcnt vmcnt(0)" ::: "memory");
        __syncthreads();
        if (tid == 0) { unsigned* cp = cnt + 64 * batch; __hip_atomic_fetch_add(cp, 1u, __ATOMIC_RELAXED, __HIP_MEMORY_SCOPE_AGENT);
            unsigned sp = 0; while (__hip_atomic_load(cp, __ATOMIC_RELAXED, __HIP_MEMORY_SCOPE_AGENT) < 2u) { __builtin_amdgcn_s_sleep(1); if (++sp > (1u << 22)) break; } }
        __syncthreads();
        if (tid < 256) { float sm = 0.f, sq = 0.f;
#pragma unroll
            for (int w = 0; w < 2; ++w) { const unsigned long long v = __hip_atomic_load(xslots + ((size_t)(batch * 256 + tid) * 2 + w), __ATOMIC_RELAXED, __HIP_MEMORY_SCOPE_AGENT);
                sm += __uint_as_float((unsigned)v); sq += __uint_as_float((unsigned)(v >> 32)); }
            const float mean = sm * (1.f / 512.f); const float var = fmaxf(sq * (1.f / 512.f) - mean * mean, 0.f);
            S[tid * 2] = mean; S[tid * 2 + 1] = rsqrtf(var + 1e-6f); }
        __syncthreads();
#pragma unroll
        for (int ai = 0; ai < 2; ++ai)
#pragma unroll
            for (int m = 0; m < 4; ++m) { const int gi = ai * 4 + m, sl = gi & 1;
                if (gi < 7) GLOADG(gi + 1, (gi + 1) & 1);
                int rl = ai * HALF + wr * 64 + m * 16 + fr; asm volatile("" : "+v"(rl));
                const float mean = S[rl * 2], rstd = S[rl * 2 + 1];
                const size_t off = ((size_t)b * 4096 + n * 256 + rl) * 4096 + hh * 512 + u.pn * 256 + wc * 32 + 8 * fq;
#pragma unroll
                for (int bj = 0; bj < 2; ++bj) { const u32x4 gr = gpl[sl][bj];
                    const float gv[8] = {bf_lo(gr.x), bf_hi(gr.x), bf_lo(gr.y), bf_hi(gr.y), bf_lo(gr.z), bf_hi(gr.z), bf_lo(gr.w), bf_hi(gr.w)};
                    f32x4 y0, y1;
#pragma unroll
                    for (int j = 0; j < 4; ++j) { y0[j] = (acc[ai][bj][m][0][j] - mean) * rstd * gv[j] / (1.f + __expf(-gv[j])); y1[j] = (acc[ai][bj][m][1][j] - mean) * rstd * gv[4 + j] / (1.f + __expf(-gv[4 + j])); }
                    *(u32x4*)(Y + off + bj * HALF) = pack8(y0, y1); }
                asm volatile("" ::: "memory"); }
#undef GLOADG
        __syncthreads();
    }
};
struct EpiFoxIn {
    static constexpr bool PERM = true;
    bf16* O; const float* qg; const float* kg; PG8_LAS unsigned char* xl;
    DI void operator()(f32x4 (&acc)[2][2][4][2], const Unit& u, int wr, int wc, int fr, int fq) const {
        const int row0 = u.pm * BM + wr * 64 + fr, col0 = u.pn * BM + wc * 32 + 8 * fq;
        if (u.pn < 16) {
            const float* gn = (u.pn < 8 ? qg : kg) + wc * 32 + 8 * fq;
            const int tid = (wr * 4 + wc) * 64 + fq * 16 + fr;
            PG8_LAS float* P = (PG8_LAS float*)xl; PG8_LAS float* S = (PG8_LAS float*)(xl + 8192);
#pragma unroll
            for (int ai = 0; ai < 2; ++ai)
#pragma unroll
                for (int m = 0; m < 4; ++m) { const int rl = ai * HALF + wr * 64 + m * 16 + fr;
#pragma unroll
                    for (int bj = 0; bj < 2; ++bj) { const f32x4 a0 = acc[ai][bj][m][0], a1 = acc[ai][bj][m][1];
                        float ss = (a0[0] * a0[0] + a0[1] * a0[1]) + (a0[2] * a0[2] + a0[3] * a0[3]) + (a1[0] * a1[0] + a1[1] * a1[1]) + (a1[2] * a1[2] + a1[3] * a1[3]);
                        ss += __shfl_xor(ss, 16); ss += __shfl_xor(ss, 32);
                        if (fq == 0) P[(rl * 2 + bj) * 4 + wc] = ss; } }
            __syncthreads();
            { const float ss = (P[tid * 4] + P[tid * 4 + 1]) + (P[tid * 4 + 2] + P[tid * 4 + 3]); S[tid] = rsqrtf(ss * (1.f / 128.f) + 1e-6f); }
            __syncthreads();
            const f32x4 g0 = *(const f32x4*)(gn), g1 = *(const f32x4*)(gn + 4);
#pragma unroll
            for (int ai = 0; ai < 2; ++ai)
#pragma unroll
                for (int m = 0; m < 4; ++m) { int rl = ai * HALF + wr * 64 + m * 16 + fr; asm volatile("" : "+v"(rl)); bf16* rowp = O + (size_t)(u.pm * BM + rl) * 8192 + col0;
#pragma unroll
                    for (int bj = 0; bj < 2; ++bj) { const float r = S[rl * 2 + bj]; *(u32x4*)(rowp + bj * HALF) = pack8(acc[ai][bj][m][0] * r * g0, acc[ai][bj][m][1] * r * g1); }
                    asm volatile("" ::: "memory"); }
            __syncthreads();
        } else {
#pragma unroll
            for (int ai = 0; ai < 2; ++ai)
#pragma unroll
                for (int m = 0; m < 4; ++m) { int rr = row0 + ai * HALF + m * 16; asm volatile("" : "+v"(rr)); bf16* rowp = O + (size_t)rr * 8192 + col0;
#pragma unroll
                    for (int bj = 0; bj < 2; ++bj) *(u32x4*)(rowp + bj * HALF) = pack8(acc[ai][bj][m][0], acc[ai][bj][m][1]); }
        }
    }
};
struct EpiRetNat {
    static constexpr bool PERM = true;
    bf16* ACAT; bf16* KNAT; bf16* GATE; const float* cosT; const float* sinT; const float* gpow; bf16* KDT; const float* kdec;
    DI void operator()(const f32x4 (&acc)[2][2][4][2], const Unit& u, int wr, int wc, int fr, int fq) const {
        const int b = u.pm >> 4, n = u.pm & 15;
        if (u.pn < 16) {
            const bool isq = u.pn < 8; const int hh = u.pn & 7; const int batch = (b * 8 + hh) * 16 + n;
            const int c0 = wc * 32 + 8 * fq;
#pragma unroll
            for (int ai = 0; ai < 2; ++ai)
#pragma unroll
                for (int m = 0; m < 4; ++m) {
                    int rl = ai * HALF + wr * 64 + m * 16 + fr; asm volatile("" : "+v"(rl)); const int pos = n * 256 + rl;
                    const float sc = isq ? gpow[hh * 260 + rl + 1] : 0.0625f;
                    f32x4 y1[2], y2[2];
#pragma unroll
                    for (int n2 = 0; n2 < 2; ++n2) {
                        const f32x4 cs = *(const f32x4*)(cosT + (size_t)pos * 128 + c0 + 4 * n2), sn = *(const f32x4*)(sinT + (size_t)pos * 128 + c0 + 4 * n2);
                        const f32x4 x1 = acc[ai][0][m][n2], x2 = acc[ai][1][m][n2];
                        y1[n2] = (x1 * cs - x2 * sn) * sc; y2[n2] = (x1 * sn + x2 * cs) * sc; }
                    bf16* dst = isq ? (ACAT + ((size_t)batch * 256 + rl) * 512 + 256 + c0) : (KNAT + ((size_t)batch * 256 + rl) * 256 + c0);
                    *(u32x4*)(dst) = pack8(y1[0], y1[1]); *(u32x4*)(dst + HALF) = pack8(y2[0], y2[1]);
                    if (!isq) {
                        const float kd = kdec[hh * 256 + rl]; const bool odd = (fr & 1) != 0;
                        bf16* kt = KDT + ((size_t)batch * 256 + c0 + (odd ? HALF : 0)) * 256 + (rl & ~1);
#pragma unroll
                        for (int n2 = 0; n2 < 2; ++n2)
#pragma unroll
                            for (int j = 0; j < 4; ++j) { const float a = y1[n2][j] * kd, b = y2[n2][j] * kd;
                                const float pa = __shfl_xor(a, 1), pb = __shfl_xor(b, 1);
                                const unsigned w = odd ? cvt_pk_bf16(pb, b) : cvt_pk_bf16(a, pa);
                                *(unsigned*)(kt + (size_t)(4 * n2 + j) * 256) = w; }
                    }
                    asm volatile("" ::: "memory");
                }
        } else {
            const int row0 = u.pm * BM + wr * 64 + fr, col0 = (u.pn - 16) * BM + wc * 32 + 8 * fq;
#pragma unroll
            for (int ai = 0; ai < 2; ++ai)
#pragma unroll
                for (int m = 0; m < 4; ++m) { int rr = row0 + ai * HALF + m * 16; asm volatile("" : "+v"(rr)); bf16* rowp = GATE + (size_t)rr * 4096 + col0;
#pragma unroll
                    for (int bj = 0; bj < 2; ++bj) *(u32x4*)(rowp + bj * HALF) = pack8(acc[ai][bj][m][0], acc[ai][bj][m][1]); }
        }
    }
};
struct EpiRetSwap {
    static constexpr bool PERM = true;
    bf16* BCAT;
    DI void operator()(const f32x4 (&acc)[2][2][4][2], const Unit& u, int wr, int wc, int fr, int fq) const {
        const int b = u.pn >> 4, n = u.pn & 15;
        const int vt = u.pm, hh = vt >> 1, voff = (vt & 1) * 256, batch = (b * 8 + hh) * 16 + n;
#pragma unroll
        for (int ai = 0; ai < 2; ++ai)
#pragma unroll
            for (int m = 0; m < 4; ++m) { int v = voff + ai * HALF + wr * 64 + m * 16 + fr; asm volatile("" : "+v"(v)); bf16* rowp = BCAT + ((size_t)batch * 512 + v) * 512 + wc * 32 + 8 * fq;
#pragma unroll
                for (int bj = 0; bj < 2; ++bj) *(u32x4*)(rowp + bj * HALF) = pack8(acc[ai][bj][m][0], acc[ai][bj][m][1]); }
    }
};
struct EpiU {
    static constexpr bool PERM = true;
    bf16* U;
    DI void operator()(const f32x4 (&acc)[2][2][4][2], const Unit& u, int wr, int wc, int fr, int fq) const {
#pragma unroll
        for (int ai = 0; ai < 2; ++ai)
#pragma unroll
            for (int m = 0; m < 4; ++m) { int v = u.pn * 256 + ai * HALF + wr * 64 + m * 16 + fr; asm volatile("" : "+v"(v)); bf16* rowp = U + ((size_t)u.pm * 512 + v) * 256 + wc * 32 + 8 * fq;
#pragma unroll
                for (int bj = 0; bj < 2; ++bj) *(u32x4*)(rowp + bj * HALF) = pack8(acc[ai][bj][m][0], acc[ai][bj][m][1]); }
    }
};
struct EpiT {
    static constexpr bool PERM = true;
    bf16* ACAT; const float* ginv;
    DI void operator()(const f32x4 (&acc)[2][2][4][2], const Unit& u, int wr, int wc, int fr, int fq) const {
        const int hh = (u.pm >> 4) & 7;
#pragma unroll
        for (int ai = 0; ai < 2; ++ai)
#pragma unroll
            for (int m = 0; m < 4; ++m) { int q = ai * HALF + wr * 64 + m * 16 + fr; asm volatile("" : "+v"(q)); bf16* rowp = ACAT + ((size_t)u.pm * 256 + q) * 512 + wc * 32 + 8 * fq;
#pragma unroll
                for (int bj = 0; bj < 2; ++bj) { const int k0 = bj * HALF + wc * 32 + 8 * fq; const float dq = (float)(q - k0 + 1);
                    f32x4 t[2];
#pragma unroll
                    for (int n2 = 0; n2 < 2; ++n2) { const f32x4 gi = *(const f32x4*)(ginv + hh * 256 + k0 + 4 * n2); t[n2] = acc[ai][bj][m][n2] * gi;
#pragma unroll
                        for (int j = 0; j < 4; ++j) t[n2][j] *= __builtin_amdgcn_fmed3f(dq - (float)(4 * n2 + j), 0.f, 1.f); }
                    *(u32x4*)(rowp + bj * HALF) = pack8(t[0], t[1]); }
                asm volatile("" ::: "memory"); }
    }
};
struct EpiO {
    static constexpr bool PERM = true;
    bf16* O;
    DI void operator()(const f32x4 (&acc)[2][2][4][2], const Unit& u, int wr, int wc, int fr, int fq) const {
        const int batch = u.pm, b = batch >> 7, hh = (batch >> 4) & 7, n = batch & 15;
#pragma unroll
        for (int ai = 0; ai < 2; ++ai)
#pragma unroll
            for (int m = 0; m < 4; ++m) { int rl = ai * HALF + wr * 64 + m * 16 + fr; asm volatile("" : "+v"(rl)); bf16* rowp = O + ((size_t)b * 4096 + n * 256 + rl) * 4096 + hh * 512 + u.pn * 256 + wc * 32 + 8 * fq;
#pragma unroll
                for (int bj = 0; bj < 2; ++bj) *(u32x4*)(rowp + bj * HALF) = pack8(acc[ai][bj][m][0], acc[ai][bj][m][1]); }
    }
};

#ifndef SP2_DEFAULT
#define SP2_DEFAULT true
#endif
template <class Epi, bool ALIGN_EPI = true, bool SP2 = SP2_DEFAULT>
DI void gemm_phase(PG8_LAS unsigned char* lds, const Gemm g, const Sched& S, const Epi& E, const int tid) {
    const int wid = __builtin_amdgcn_readfirstlane(tid >> 6), lane = tid & 63, wr = wid >> 2, wc = wid & 3, fr = lane & 15, fq = lane >> 4;
    const int K = g.K, nt = K / BK;
    unsigned vooffA, vooffB;
    { int R, C; stage_rc(tid * 16, R, C); const int Rb = Epi::PERM ? ((R & ~31) + perm32(R & 31)) : R;
      vooffA = (unsigned)(R * g.lda + C) * 2u; vooffB = (unsigned)(Rb * g.ldb + C) * 2u; }
    const size_t r64offA = (size_t)64 * g.lda * 2, r64offB = (size_t)64 * g.ldb * 2;
    const size_t kstep = (size_t)(BK * 2);
    const size_t hstepA = (size_t)HALF * g.lda * 2, hstepB = (size_t)HALF * g.ldb * 2;
    const unsigned ldsw = (unsigned)wid * 1024u;
    const int aoff = lds_byte(wr * 64 + fr, fq * 8), boff = lds_byte(wc * 32 + fr, fq * 8);
#define PG8_SA(b, h) (((b) * 2 + (h)) * HTB)
#define PG8_SB(b, h) ((4 + (b) * 2 + (h)) * HTB)
#define PG8_STAGE(bufoff, gbase, voff) do { _Pragma("unroll") for (int _i = 0; _i < 2; ++_i) \
        __builtin_amdgcn_global_load_lds((const unsigned*)((const char*)(gbase) + (size_t)_i * r64##voff + (vo##voff)), (PG8_LAS unsigned*)(lds + (bufoff) + ldsw + _i * 8192), 16, 0, 0); } while (0)
#define PG8_LDA(dst, b, h) do { _Pragma("unroll") for (int m = 0; m < 4; ++m) _Pragma("unroll") for (int k = 0; k < 2; ++k) dst[m][k] = *(const PG8_LAS bf16x8*)(lds + PG8_SA(b, h) + aoff + m * 2048 + k * 1024); } while (0)
#define PG8_LDB(dst, b, h) do { _Pragma("unroll") for (int n = 0; n < 2; ++n) _Pragma("unroll") for (int k = 0; k < 2; ++k) dst[n][k] = *(const PG8_LAS bf16x8*)(lds + PG8_SB(b, h) + boff + n * 2048 + k * 1024); } while (0)
#define PG8_MMA(ai, bj, At, Bt) do { __builtin_amdgcn_s_setprio(1); _Pragma("unroll") for (int m = 0; m < 4; ++m) _Pragma("unroll") for (int n = 0; n < 2; ++n) _Pragma("unroll") for (int k = 0; k < 2; ++k) \
        acc[ai][bj][m][n] = __builtin_amdgcn_mfma_f32_16x16x32_bf16(Bt[n][k], At[m][k], acc[ai][bj][m][n], 0, 0, 0); __builtin_amdgcn_s_setprio(0); } while (0)
#define PG8_WAIT_V(n) asm volatile("s_waitcnt vmcnt(" #n ")" ::: "memory")
#define PG8_WAIT_L(n) asm volatile("s_waitcnt lgkmcnt(" #n ")" ::: "memory")
#define PG8_BAR __builtin_amdgcn_s_barrier()
#define PG8_SCHED __builtin_amdgcn_sched_barrier(0)
    Unit cur, nxt; int ui = 0;
    if (!S.next(0, cur)) return;
    f32x4 acc[2][2][4][2];
#pragma unroll
    for (int a = 0; a < 2; ++a)
#pragma unroll
        for (int b = 0; b < 2; ++b)
#pragma unroll
            for (int m = 0; m < 4; ++m)
#pragma unroll
                for (int n = 0; n < 2; ++n) acc[a][b][m][n] = (f32x4){0.f, 0.f, 0.f, 0.f};
    bf16x8 At[4][2], B0[2][2], B1[2][2];
    const char* cA = (const char*)g.A + cur.aoff; const char* cB = (const char*)g.Bt + cur.boff;
    if constexpr (SP2) {
        PG8_STAGE(PG8_SB(0, 0), cB, offB); PG8_STAGE(PG8_SB(0, 1), cB + hstepB, offB); PG8_STAGE(PG8_SA(0, 0), cA, offA); PG8_STAGE(PG8_SA(0, 1), cA + hstepA, offA);
        if (wr == 1) PG8_BAR;
        PG8_WAIT_V(2); PG8_BAR;
        PG8_STAGE(PG8_SB(1, 0), cB + kstep, offB); PG8_STAGE(PG8_SA(1, 0), cA + kstep, offA); PG8_STAGE(PG8_SB(1, 1), cB + hstepB + kstep, offB);
        PG8_WAIT_V(6); PG8_BAR;
    } else {
        PG8_STAGE(PG8_SB(0, 0), cB, offB); PG8_STAGE(PG8_SA(0, 0), cA, offA); PG8_STAGE(PG8_SB(0, 1), cB + hstepB, offB); PG8_STAGE(PG8_SA(0, 1), cA + hstepA, offA);
        if (wr == 1) PG8_BAR;
        PG8_WAIT_V(4); PG8_BAR;
        PG8_STAGE(PG8_SB(1, 0), cB + kstep, offB); PG8_STAGE(PG8_SA(1, 0), cA + kstep, offA); PG8_STAGE(PG8_SB(1, 1), cB + hstepB + kstep, offB);
        PG8_WAIT_V(6); PG8_BAR;
    }
    for (;;) {
        const bool has_next = S.next(ui + 1, nxt);
        const char* nA = has_next ? (const char*)g.A + nxt.aoff : cA; const char* nB = has_next ? (const char*)g.Bt + nxt.boff : cB;
#pragma unroll 1
        for (int t = 0; t < nt; t += 2) {
            const bool last = (t == nt - 2);
            const char* a1 = cA + (size_t)(t + 1) * kstep;
            const char* a2 = last ? nA : cA + (size_t)(t + 2) * kstep; const char* b2 = last ? nB : cB + (size_t)(t + 2) * kstep;
            const char* a3 = a2 + kstep; const char* b3 = b2 + kstep;
            if constexpr (SP2) {
            PG8_LDB(B0, 0, 0); PG8_LDB(B1, 0, 1); PG8_SCHED; PG8_LDA(At, 0, 0); PG8_STAGE(PG8_SA(1, 1), a1 + hstepA, offA);
            PG8_WAIT_V(8); PG8_WAIT_L(0); PG8_BAR; PG8_MMA(0, 0, At, B0); PG8_MMA(0, 1, At, B1); PG8_BAR; PG8_SCHED;
            PG8_LDA(At, 0, 1); PG8_STAGE(PG8_SB(0, 0), b2, offB); PG8_STAGE(PG8_SB(0, 1), b2 + hstepB, offB); PG8_STAGE(PG8_SA(0, 0), a2, offA);
            PG8_WAIT_V(8); PG8_WAIT_L(0); PG8_BAR; PG8_MMA(1, 0, At, B0); PG8_MMA(1, 1, At, B1); PG8_BAR; PG8_SCHED;
            PG8_LDB(B0, 1, 0); PG8_LDB(B1, 1, 1); PG8_SCHED; PG8_LDA(At, 1, 0); PG8_STAGE(PG8_SA(0, 1), a2 + hstepA, offA);
            PG8_WAIT_V(8); PG8_WAIT_L(0); PG8_BAR; PG8_MMA(0, 0, At, B0); PG8_MMA(0, 1, At, B1); PG8_BAR; PG8_SCHED;
            PG8_LDA(At, 1, 1); PG8_STAGE(PG8_SB(1, 0), b3, offB); PG8_STAGE(PG8_SB(1, 1), b3 + hstepB, offB); PG8_STAGE(PG8_SA(1, 0), a3, offA);
            PG8_WAIT_V(8); PG8_WAIT_L(0); PG8_BAR; PG8_MMA(1, 0, At, B0); PG8_MMA(1, 1, At, B1); PG8_BAR; PG8_SCHED;
            } else {
            PG8_LDB(B0, 0, 0); PG8_SCHED; PG8_LDA(At, 0, 0); PG8_STAGE(PG8_SA(1, 1), a1 + hstepA, offA);
            PG8_WAIT_L(8); PG8_BAR; PG8_WAIT_L(0); PG8_MMA(0, 0, At, B0); PG8_BAR; PG8_SCHED;
            PG8_LDB(B1, 0, 1); PG8_STAGE(PG8_SB(0, 0), b2, offB);
            PG8_BAR; PG8_WAIT_L(0); PG8_MMA(0, 1, At, B1); PG8_BAR;
            PG8_LDA(At, 0, 1); PG8_STAGE(PG8_SA(0, 0), a2, offA);
            PG8_BAR; PG8_WAIT_L(0); PG8_MMA(1, 0, At, B0); PG8_BAR; PG8_SCHED;
            PG8_STAGE(PG8_SB(0, 1), b2 + hstepB, offB);
            PG8_WAIT_V(6); PG8_BAR; PG8_MMA(1, 1, At, B1); PG8_BAR;
            PG8_LDB(B0, 1, 0); PG8_SCHED; PG8_LDA(At, 1, 0); PG8_STAGE(PG8_SA(0, 1), a2 + hstepA, offA);
            PG8_WAIT_L(8); PG8_BAR; PG8_WAIT_L(0); PG8_MMA(0, 0, At, B0); PG8_BAR; PG8_SCHED;
            PG8_LDB(B1, 1, 1); PG8_STAGE(PG8_SB(1, 0), b3, offB);
            PG8_BAR; PG8_WAIT_L(0); PG8_MMA(0, 1, At, B1); PG8_BAR;
            PG8_LDA(At, 1, 1); PG8_STAGE(PG8_SA(1, 0), a3, offA);
            PG8_BAR; PG8_WAIT_L(0); PG8_MMA(1, 0, At, B0); PG8_BAR; PG8_SCHED;
            PG8_STAGE(PG8_SB(1, 1), b3 + hstepB, offB);
            PG8_WAIT_V(6); PG8_BAR; PG8_MMA(1, 1, At, B1); PG8_BAR;
            }
        }
        if constexpr (ALIGN_EPI) { if (wr == 0) PG8_BAR; }
        { int te = tid; asm volatile("" : "+v"(te)); const int le = te & 63; E(acc, cur, wr, wc, le & 15, le >> 4); }
        if (!has_next) break;
#pragma unroll
        for (int a = 0; a < 2; ++a)
#pragma unroll
            for (int b = 0; b < 2; ++b)
#pragma unroll
                for (int m = 0; m < 4; ++m)
#pragma unroll
                    for (int n = 0; n < 2; ++n) acc[a][b][m][n] = (f32x4){0.f, 0.f, 0.f, 0.f};
        cur = nxt; cA = nA; cB = nB; ++ui;
        if constexpr (ALIGN_EPI) { if (wr == 1) PG8_BAR; }
    }
    PG8_WAIT_V(0);
    if constexpr (!ALIGN_EPI) { if (wr == 0) PG8_BAR; }
    PG8_BAR;
#undef PG8_SA
#undef PG8_SB
#undef PG8_STAGE
#undef PG8_LDA
#undef PG8_LDB
#undef PG8_MMA
#undef PG8_WAIT_V
#undef PG8_WAIT_L
#undef PG8_BAR
#undef PG8_SCHED
}
}

namespace fa {
constexpr int D = 128, NW = 8, QBLK = 32, KVBLK = 64, QB = NW * QBLK;
constexpr int SHM_V = KVBLK * D * 2, SHM_K = KVBLK * D * 2, SHM_A = KVBLK * 4;
constexpr int NRING = 3;
constexpr int LDS_WS = NRING * SHM_V + NRING * SHM_K, LDS_BIAS = LDS_WS + NW * 64 * 4, LDS_SCAN = LDS_BIAS + 4096 * 4, LDS_BYTES = LDS_SCAN + 64;
constexpr float SCALE = 0.08838834764831845f, THR = 8.f;
constexpr int KP = 8192, OP = 2048;
#define KSWZ(row, colB) ((row) * 256 + ((colB) ^ (((row) & 7) << 4)))
#define SBAR() __builtin_amdgcn_sched_barrier(0)
DI int v_st(int k, int c) { const int kk = (k & ~0xC) | ((k & 4) << 1) | ((k & 8) >> 1); return ((kk >> 3) * 4 + (c >> 5)) * 512 + ((kk & 7) * 32 + (c & 31)) * 2; }
DI int v_rd_base(int lane) { return ((lane & 3) << 3) | (((lane >> 2) & 3) << 6) | (((lane >> 4) & 1) << 5) | (((lane >> 5) & 1) << 8); }
constexpr int v_rd_off(int d0, int ks, int half) { return d0 * 512 + ks * 4096 + half * 2048; }
DI int crow(int r, int hi) { return (r & 3) + 8 * (r >> 2) + 4 * hi; }
DI unsigned cvtpk(float lo, float hi) { unsigned r; asm volatile("v_cvt_pk_bf16_f32 %0, %1, %2" : "=v"(r) : "v"(lo), "v"(hi)); return r; }
DI bf16x8 load8(const bf16* p) { return *reinterpret_cast<const bf16x8*>(p); }
DI void mask_tile(f32x16& p0, f32x16& p1, int dq) {
    const float NEG = -__builtin_inff();
#pragma unroll
    for (int r = 0; r < 16; ++r) {
        const int c = (r & 3) + 8 * (r >> 2);
        if (dq - c < 0) p0[r] = NEG;
        if (dq - c - 32 < 0) p1[r] = NEG;
    }
}
DI void partialSM(f32x16& p0, f32x16& p1, float& m_reg, float& mn, float& alpha) {
    float pmax = p0[0]; for (int r = 1; r < 16; ++r) pmax = fmaxf(pmax, p0[r]); for (int r = 0; r < 16; ++r) pmax = fmaxf(pmax, p1[r]);
    { auto rr = __builtin_amdgcn_permlane32_swap(__float_as_uint(pmax), __float_as_uint(pmax), false, false);
      pmax = fmaxf(__uint_as_float(rr[0]), __uint_as_float(rr[1])); }
    constexpr float C2 = 1.4426950408889634f * SCALE;
    if (__builtin_expect(__all((pmax - m_reg) * SCALE <= THR), 1)) { mn = m_reg; alpha = 1.f; }
    else { mn = fmaxf(m_reg, pmax); alpha = __builtin_amdgcn_exp2f((m_reg - mn) * C2); m_reg = mn; }
    const float mnL = -mn * C2;
    for (int r = 0; r < 16; ++r) p0[r] = fmaf(p0[r], C2, mnL); for (int r = 0; r < 16; ++r) p1[r] = fmaf(p1[r], C2, mnL);
    for (int r = 0; r < 16; ++r) p0[r] = __builtin_amdgcn_exp2f(p0[r]);
}
DI void finishSM(f32x16& p0, f32x16& p1, float alpha, float& l_reg, bf16x8& pa0, bf16x8& pa1, bf16x8& pa2, bf16x8& pa3) {
    for (int r = 0; r < 16; ++r) p1[r] = __builtin_amdgcn_exp2f(p1[r]);
    float ps = 0; for (int r = 0; r < 16; ++r) ps += p0[r]; for (int r = 0; r < 16; ++r) ps += p1[r];
    { auto rr = __builtin_amdgcn_permlane32_swap(__float_as_uint(ps), __float_as_uint(ps), false, false);
      ps = __uint_as_float(rr[0]) + __uint_as_float(rr[1]); }
    l_reg = l_reg * alpha + ps;
#define PK4(P, B_, OUT) do { unsigned a0 = cvtpk(P[B_+0], P[B_+1]), a1 = cvtpk(P[B_+2], P[B_+3]);                          \
        unsigned b0 = cvtpk(P[B_+4], P[B_+5]), b1 = cvtpk(P[B_+6], P[B_+7]);                                             \
        auto r0 = __builtin_amdgcn_permlane32_swap(a0, b0, false, false); auto r1 = __builtin_amdgcn_permlane32_swap(a1, b1, false, false); \
        u32x4 w = {r0[0], r1[0], r0[1], r1[1]}; OUT = *reinterpret_cast<bf16x8*>(&w); } while (0)
    PK4(p0, 0, pa0); PK4(p0, 8, pa1); PK4(p1, 0, pa2); PK4(p1, 8, pa3);
#undef PK4
}
DI void qkt(f32x16& p0, f32x16& p1, const char* K_lds, const int kslot, const char* bias_t, int r32, int hi, const bf16x8* qr) {
    {
        const char* ab = bias_t + hi * 16;
#pragma unroll
        for (int g = 0; g < 4; ++g) { const f32x4 b0 = *reinterpret_cast<const f32x4*>(ab + g * 32), b1 = *reinterpret_cast<const f32x4*>(ab + 128 + g * 32);
            p0[4 * g] = b0[0]; p0[4 * g + 1] = b0[1]; p0[4 * g + 2] = b0[2]; p0[4 * g + 3] = b0[3];
            p1[4 * g] = b1[0]; p1[4 * g + 1] = b1[1]; p1[4 * g + 2] = b1[2]; p1[4 * g + 3] = b1[3]; }
    }
    const char* kb[4];
#pragma unroll
    for (int dd = 0; dd < 4; ++dd) kb[dd] = K_lds + kslot * SHM_K + KSWZ(r32, (dd * 16 + hi * 8) * 2);
#pragma unroll
    for (int d0 = 0; d0 < 8; ++d0) { const char* a = kb[d0 & 3] + (d0 >> 2) * 128;
        bf16x8 b0 = *reinterpret_cast<const bf16x8*>(a);
        bf16x8 b1 = *reinterpret_cast<const bf16x8*>(a + 32 * 256);
        p0 = __builtin_amdgcn_mfma_f32_32x32x16_bf16(b0, qr[d0], p0, 0, 0, 0);
        p1 = __builtin_amdgcn_mfma_f32_32x32x16_bf16(b1, qr[d0], p1, 0, 0, 0); }
}
DI void pv_tile(f32x16* o, const int vb0, bf16x8 pa0, bf16x8 pa1, bf16x8 pa2, bf16x8 pa3) {
#define TRRD(dst, off) asm volatile("ds_read_b64_tr_b16 %0, %1 offset:%2" : "=&v"(dst) : "v"(vb0), "i"(off) : "memory")
#define PV_D0(d0) do { s16x4 l0, l1, l2, l3, h0, h1, h2, h3; constexpr int b_ = v_rd_off(d0, 0, 0); \
        TRRD(l0, b_); TRRD(h0, b_ + 2048); TRRD(l1, b_ + 4096); TRRD(h1, b_ + 6144); TRRD(l2, b_ + 8192); TRRD(h2, b_ + 10240); TRRD(l3, b_ + 12288); TRRD(h3, b_ + 14336); \
        asm volatile("s_waitcnt lgkmcnt(0)" ::: "memory"); SBAR();   \
        o[d0] = __builtin_amdgcn_mfma_f32_32x32x16_bf16(pa0, (bf16x8){l0[0], l0[1], l0[2], l0[3], h0[0], h0[1], h0[2], h0[3]}, o[d0], 0, 0, 0);   \
        o[d0] = __builtin_amdgcn_mfma_f32_32x32x16_bf16(pa1, (bf16x8){l1[0], l1[1], l1[2], l1[3], h1[0], h1[1], h1[2], h1[3]}, o[d0], 0, 0, 0);   \
        o[d0] = __builtin_amdgcn_mfma_f32_32x32x16_bf16(pa2, (bf16x8){l2[0], l2[1], l2[2], l2[3], h2[0], h2[1], h2[2], h2[3]}, o[d0], 0, 0, 0);   \
        o[d0] = __builtin_amdgcn_mfma_f32_32x32x16_bf16(pa3, (bf16x8){l3[0], l3[1], l3[2], l3[3], h3[0], h3[1], h3[2], h3[3]}, o[d0], 0, 0, 0); } while (0)
    PV_D0(0); PV_D0(1); PV_D0(2); PV_D0(3);
#undef PV_D0
#undef TRRD
}
struct BlockRef { const bf16* Q; const bf16* KV; bf16* O; int P0; };
struct Seam { bf16x8 qr[8]; bf16x8 st_v0, st_v1, st_k0, st_k1; };
#define ROW(p, k0, rr) (((p) + (size_t)((k0) + (rr)) * KP) + toff)
#define VMW() asm volatile("s_waitcnt vmcnt(0)" ::: "memory")
#define VMWN(n) asm volatile("s_waitcnt vmcnt(%0)" :: "i"(n) : "memory")
#define SLOAD_H(Kp, Vp, Ap, k0, bf) do { S.st_v0 = load8(ROW(Vp, k0, 0)); S.st_v1 = load8(ROW(Vp, k0, 32));              \
                         S.st_k0 = load8(ROW(Kp, k0, 0)); S.st_k1 = load8(ROW(Kp, k0, 32)); \
                         } while (0)
#define SWRITE_HK(bf) do { *(bf16x8*)(K_lds + (bf) * SHM_K + kws) = S.st_k0; *(bf16x8*)(K_lds + (bf) * SHM_K + kws + 32 * 256) = S.st_k1; } while (0)
#define SWRITE_HV(bf) do { *(bf16x8*)(V_lds + (bf) * SHM_V + vst0) = S.st_v0; *(bf16x8*)(V_lds + (bf) * SHM_V + vst1) = S.st_v1; } while (0)
#define SWRITE_H(bf) do { SWRITE_HV(bf); SWRITE_HK(bf); } while (0)
#define HEAD_BIAS(bh_) do { int tl_ = tid; asm volatile("" : "+v"(tl_));     \
        const int lane_ = tl_ & 63, wave_ = __builtin_amdgcn_readfirstlane(tl_ >> 6); const float* ls_ = AUG + (size_t)(bh_) * 4096 + tl_ * 8; \
        const f32x4 a0_ = *(const f32x4*)ls_, a1_ = *(const f32x4*)(ls_ + 4); float v_[8]; float run_ = 0.f; \
        _Pragma("unroll") for (int e_ = 0; e_ < 4; ++e_) { run_ += a0_[e_]; v_[e_] = run_; } \
        _Pragma("unroll") for (int e_ = 0; e_ < 4; ++e_) { run_ += a1_[e_]; v_[4 + e_] = run_; } \
        float incl_ = run_; \
        _Pragma("unroll") for (int o_ = 1; o_ < 64; o_ <<= 1) { const float t_ = __int_as_float(__builtin_amdgcn_ds_bpermute(((lane_ - o_) & 63) << 2, __float_as_int(incl_))); if (lane_ >= o_) incl_ += t_; } \
        float* wt_ = (float*)(lds + LDS_SCAN); \
        if (lane_ == 63) wt_[wave_] = incl_; \
        __syncthreads(); \
        float base_ = incl_ - run_; for (int w_ = 0; w_ < wave_; ++w_) base_ += wt_[w_]; \
        f32x4 o0_, o1_; \
        _Pragma("unroll") for (int e_ = 0; e_ < 4; ++e_) { o0_[e_] = -(base_ + v_[e_]) * 11.313708498984761f; o1_[e_] = -(base_ + v_[4 + e_]) * 11.313708498984761f; } \
        *(f32x4*)(lds + LDS_BIAS + tl_ * 32) = o0_; *(f32x4*)(lds + LDS_BIAS + tl_ * 32 + 16) = o1_; \
        __syncthreads(); } while (0)
DI void prime(const BlockRef& cur, char* lds, Seam& S, const int tid, const float* AUG, const int bh) {
    const int wid = __builtin_amdgcn_readfirstlane(tid >> 6), lane = tid & 63, r32 = lane & 31, hi = lane >> 5;
    const int sr = tid >> 4, sc = (tid & 15) * 8, kws = KSWZ(sr, sc * 2); const unsigned toff = (unsigned)(sr * KP + sc); char* K_lds = lds + NRING * SHM_V;
    for (int d0 = 0; d0 < 8; ++d0) S.qr[d0] = load8(cur.Q + (size_t)(wid * QBLK + r32) * KP + d0 * 16 + hi * 8);
    SLOAD_H(cur.KV + 2048, cur.KV + 4096, 0, 0, 0);
    HEAD_BIAS(bh);
    VMW(); SWRITE_HK(0);
    __syncthreads();
}
DI void block(const BlockRef& cur, const BlockRef& nxt, char* lds, Seam& S, const int tid) {
    const int wid = __builtin_amdgcn_readfirstlane(tid >> 6), lane = tid & 63, r32 = lane & 31, hi = lane >> 5;
    const int NT = (cur.P0 + QB - 1) / KVBLK + 1;
    const int qlo = cur.P0 + wid * QBLK, qm = qlo + r32 - 4 * hi;
    char* V_lds = lds; char* K_lds = lds + NRING * SHM_V; const char* B_lds = lds + LDS_BIAS;
    float* ws = (float*)(lds + LDS_WS) + wid * 64; float* li_l = ws, * al_l = ws + 32;
    float m_reg = -1e30f, l_reg = 0; f32x16 o[4] = {};
    const int sr = tid >> 4, sc = (tid & 15) * 8, vst0 = v_st(sr, sc), vst1 = v_st(32 + sr, sc), kws = KSWZ(sr, sc * 2); const unsigned toff = (unsigned)(sr * KP + sc);
    const int vb0 = (int)(uintptr_t)V_lds + v_rd_base(lane);
    const bf16* Kh = cur.KV + 2048; const bf16* Vh = cur.KV + 4096;
#define RESC(a) do { if (__any((a) < 1.f)) { if (hi == 0) al_l[r32] = (a); asm volatile("s_waitcnt lgkmcnt(0)" ::: "memory");              \
                     for (int d_ = 0; d_ < 4; ++d_) for (int r = 0; r < 16; ++r) o[d_][r] *= al_l[crow(r, hi)]; } } while (0)
#define KBASE(t) ((t) * KVBLK)
#define MASKT(P0_, P1_, t) do { const int kb_ = KBASE(t); if (kb_ + KVBLK - 1 > qlo) mask_tile(P0_, P1_, qm - kb_); } while (0)
    constexpr int NQL = 8;
#define SEAM_K0() do { VMWN(NQL); SWRITE_HK(0); SBAR(); } while (0)
    f32x16 pA0, pA1, pB0, pB1; float mnA, mnB, alA, alB; bf16x8 pa0, pa1, pa2, pa3;
    SWRITE_HV(0); SBAR();
    if (NT > 1) { SLOAD_H(Kh, Vh, 0, KBASE(1), 1); }
    SBAR(); qkt(pA0, pA1, K_lds, 0, B_lds, r32, hi, S.qr);
    MASKT(pA0, pA1, 0); partialSM(pA0, pA1, m_reg, mnA, alA);
    if (NT > 1) { VMW(); SWRITE_H(1); }
    __syncthreads();
#define HALF_STEP(PX0, PX1, mnX, alX, PY0, PY1, alY, t) do {                                                      \
        SBAR(); qkt(PX0, PX1, K_lds, rt, B_lds + KBASE(t) * 4, r32, hi, S.qr);                                             \
        finishSM(PY0, PY1, alY, l_reg, pa0, pa1, pa2, pa3); SBAR();                                                           \
        if ((t) + 1 < NT) { SLOAD_H(Kh, Vh, 0, KBASE((t) + 1), 0); SBAR(); }                                               \
        pv_tile(o, vb0 + rp * SHM_V, pa0, pa1, pa2, pa3); MASKT(PX0, PX1, (t)); partialSM(PX0, PX1, m_reg, mnX, alX);                                        \
        if ((t) + 1 < NT) { VMW(); SWRITE_H(rn); }                                                                          \
        RESC(alX); __syncthreads();                                                                                          \
        rp = rt; rt = rn; rn = (rn == NRING - 1) ? 0 : rn + 1; } while (0)
    int rp = 0, rt = 1, rn = 2;
    for (int t = 1; t + 1 < NT; t += 2) {
        HALF_STEP(pB0, pB1, mnB, alB, pA0, pA1, alA, t);
        HALF_STEP(pA0, pA1, mnA, alA, pB0, pB1, alB, t + 1);
    }
    const bool even = (NT & 1) == 0;
    if (even) { SBAR(); qkt(pB0, pB1, K_lds, rt, B_lds + KBASE(NT - 1) * 4, r32, hi, S.qr); SBAR(); }
    SLOAD_H(nxt.KV + 2048, nxt.KV + 4096, 0, 0, 0); SBAR();
#pragma unroll
    for (int d0 = 0; d0 < 8; ++d0) S.qr[d0] = load8(nxt.Q + (size_t)(wid * QBLK + r32) * KP + d0 * 16 + hi * 8);
    SBAR();
    finishSM(pA0, pA1, alA, l_reg, pa0, pa1, pa2, pa3); SBAR();
    pv_tile(o, vb0 + rp * SHM_V, pa0, pa1, pa2, pa3);
    if (even) { MASKT(pB0, pB1, NT - 1); partialSM(pB0, pB1, m_reg, mnB, alB); __syncthreads(); RESC(alB);
        finishSM(pB0, pB1, alB, l_reg, pa0, pa1, pa2, pa3); SBAR(); pv_tile(o, vb0 + rt * SHM_V, pa0, pa1, pa2, pa3); }
    SBAR(); SEAM_K0();
    if (hi == 0) li_l[r32] = l_reg; asm volatile("s_waitcnt lgkmcnt(0)" ::: "memory");
    float rli[16];
#pragma unroll
    for (int r = 0; r < 16; ++r) rli[r] = __builtin_amdgcn_rcpf(li_l[crow(r, hi)]);
    { int te = tid; asm volatile("" : "+v"(te)); const int r32e = te & 31, hie = (te >> 5) & 1;
    bf16* Ow = cur.O + (size_t)(wid * QBLK) * OP + r32e; const bf16* Gw = cur.Q + 6144 + (size_t)(wid * QBLK) * KP + r32e;
    bf16 graw[2][16];
#define GLOAD(g_, sl_) do { int orow_ = 8 * (g_) + 4 * hie; asm volatile("" : "+v"(orow_)); const bf16* gp_ = Gw + (size_t)orow_ * KP; \
        _Pragma("unroll") for (int i_ = 0; i_ < 4; ++i_) _Pragma("unroll") for (int d_ = 0; d_ < 4; ++d_) graw[sl_][i_ * 4 + d_] = gp_[(size_t)i_ * KP + d_ * 32]; } while (0)
    GLOAD(0, 0);
#pragma unroll
    for (int g = 0; g < 4; ++g) {
        if (g < 3) GLOAD(g + 1, (g + 1) & 1);
        int orow = 8 * g + 4 * hie; asm volatile("" : "+v"(orow)); bf16* op = Ow + (size_t)orow * OP;
#pragma unroll
        for (int i = 0; i < 4; ++i) { const int r = 4 * g + i;
#pragma unroll
            for (int d0 = 0; d0 < 4; ++d0) { const float gt = bf2f(graw[g & 1][i * 4 + d0]);
                const float v = o[d0][r] * rli[r] * gt / (1.f + __expf(-gt));
                const float vn = __shfl_xor(v, 1);
                if ((r32e & 1) == 0) *(unsigned*)(op + (size_t)i * OP + d0 * 32) = cvtpk(v, vn); } }
        asm volatile("" ::: "memory"); } }
#undef GLOAD
    __syncthreads();
#undef RESC
#undef KBASE
#undef MASKT
#undef SEAM_K0
#undef HALF_STEP
}
#undef ROW
#undef VMW
#undef VMWN
#undef SLOAD_H
#undef SWRITE_HK
#undef SWRITE_HV
#undef SWRITE_H
DI BlockRef mkref(int bh, int qb, const bf16* PROJ, const float* AUG, bf16* Y) {
    const int b = bh >> 4, h = bh & 15; BlockRef r;
    const size_t tok0 = (size_t)b * 4096;
    r.Q = PROJ + (tok0 + (size_t)qb * QB) * KP + h * 128;
    r.KV = PROJ + tok0 * KP + h * 128;
    r.O = Y + (tok0 + (size_t)qb * QB) * OP + h * 128; r.P0 = qb * QB;
    return r;
}
DI void attn_phase(char* lds, const bf16* PROJ, const float* AUG, bf16* Y, int G, int c, const int tid) {
    constexpr int total = 256;
    int L = c; if (L >= total) return;
#define ITEM_BH(L_) ((((L_) & 7) << 2) + ((L_) >> 6))
#define ITEM_X(L_) (((L_) >> 3) & 7)
    int bh = ITEM_BH(L), x = ITEM_X(L), pass = 0;
    BlockRef cur = mkref(bh, x, PROJ, AUG, Y);
    Seam S;
    prime(cur, lds, S, tid, AUG, bh);
    for (;;) {
        const bool more_pass = pass == 0, more_item = L + G < total, last = !more_pass && !more_item;
        int bhn = bh, xn = x, passn = pass + 1, Ln = L;
        if (!more_pass) { passn = 0; Ln = more_item ? L + G : L; bhn = ITEM_BH(Ln); xn = ITEM_X(Ln); }
        const BlockRef nxt = last ? cur : mkref(bhn, passn ? 15 - xn : xn, PROJ, AUG, Y);
        block(cur, nxt, lds, S, tid);
        if (last) break;
        if (bhn != bh) HEAD_BIAS(bhn);
        cur = nxt; bh = bhn; x = xn; pass = passn; L = Ln;
    }
}
}

constexpr int NTOK = 8192, DM = 2048;
constexpr size_t MiB = 1u << 20;
constexpr size_t WS_COS = 0, WS_SIN = 2 * MiB, WS_COSTT = 4 * MiB, WS_SINTT = 6 * MiB, WS_GPOW = 8 * MiB, WS_KDEC = 8 * MiB + 16384, WS_GINV = 8 * MiB + 32768;
constexpr size_t WS_BAR = 15 * MiB, WS_LNCNT = 15 * MiB + 16384, WS_GNCNT = 15 * MiB + 65536, WS_XSLOT = 13 * MiB, WS_GSLOT = 11 * MiB;
constexpr size_t WS_LOGIT = 9 * MiB, WS_AUG = 10 * MiB, WS_WFT = 12 * MiB;
constexpr size_t WS_WFI = 16 * MiB, WS_WFO = 80 * MiB, WS_WRI = 96 * MiB, WS_WRO = 192 * MiB;
constexpr size_t WS_HB = 224 * MiB, WS_H32 = 256 * MiB, WS_RA = 320 * MiB, WS_RB = 384 * MiB, WS_RK = 512 * MiB, WS_RKT = 544 * MiB, WS_RG = 576 * MiB, WS_RU = 640 * MiB, WS_END = 704 * MiB;
constexpr int LDS_BYTES = 131072 + 2048 + 10240;
#define LAS __attribute__((address_space(3)))

struct TrItem { const float* W; bf16* WT; int ldw, ldt, k0, n0; };
DI void tr_load(const TrItem& t, int lane, float (&tv)[32]) {
#pragma unroll
    for (int i = 0; i < 8; ++i) { const f32x4 v = *(const f32x4*)(t.W + (size_t)(t.k0 + 8 * i + (lane >> 3)) * t.ldw + t.n0 + (lane & 7) * 4);
        tv[4 * i] = v[0]; tv[4 * i + 1] = v[1]; tv[4 * i + 2] = v[2]; tv[4 * i + 3] = v[3]; }
}
DI void tr_store(const TrItem& t, int lane, const float (&tv)[32], LAS float* scr) {
#pragma unroll
    for (int i = 0; i < 8; ++i) { LAS float* d = scr + (8 * i + (lane >> 3)) * 33 + (lane & 7) * 4; d[0] = tv[4 * i]; d[1] = tv[4 * i + 1]; d[2] = tv[4 * i + 2]; d[3] = tv[4 * i + 3]; }
    asm volatile("s_waitcnt lgkmcnt(0)" ::: "memory");
    const int c = lane & 7;
#pragma unroll
    for (int j = 0; j < 4; ++j) { const int n = (lane >> 3) + 8 * j; const LAS float* s = scr + (8 * c) * 33 + n;
        u32x4 o; o.x = cvt_pk_bf16(s[0 * 33], s[1 * 33]); o.y = cvt_pk_bf16(s[2 * 33], s[3 * 33]); o.z = cvt_pk_bf16(s[4 * 33], s[5 * 33]); o.w = cvt_pk_bf16(s[6 * 33], s[7 * 33]);
        *(u32x4*)(t.WT + (size_t)(t.n0 + n) * t.ldt + t.k0 + 8 * c) = o; }
    asm volatile("s_waitcnt lgkmcnt(0)" ::: "memory");
}


#define XB_TMO      128
#define XB_XCNT(j)  (256  + 64 * (j))
#define XB_XSUB(j)  (1280 + 64 * (j))
#define XB_XGEN(j)  (2304 + 64 * (j))
#define XB_TOP      3328
#define XB_TOPGEN   3392
#define XCD_BAR_WORDS 3456
#define XB_SPIN_CAP (1u << 20)
DI unsigned xb_ld(unsigned* p)              { return __hip_atomic_load(p, __ATOMIC_RELAXED, __HIP_MEMORY_SCOPE_AGENT); }
DI unsigned xb_add(unsigned* p, unsigned v) { return __hip_atomic_fetch_add(p, v, __ATOMIC_RELAXED, __HIP_MEMORY_SCOPE_AGENT); }
DI unsigned xb_xcc_id() { return (unsigned)__builtin_amdgcn_s_getreg((3 << 11) | 20) & 0xFu; }
#define XB_SPIN(cond, bar) do { unsigned _sp = 0; while (cond) { __builtin_amdgcn_s_sleep(1); \
    if ((++_sp & 255u) == 0u) { if (xb_ld(&(bar)[XB_TMO])) break; if (_sp > XB_SPIN_CAP) { atomicAdd(&(bar)[XB_TMO], 1u); break; } } } } while (0)
DI void xcd_barrier_complete(unsigned* bar, unsigned x, unsigned G, unsigned& nloc, unsigned& nx) {
    unsigned sum, cnt, mine, sp = 0u;
    for (;;) {
        sum = 0u; cnt = 0u; mine = 0u;
#pragma unroll
        for (unsigned j = 0; j < 16; ++j) { const unsigned c = xb_ld(&bar[XB_XCNT(j)]); sum += c; cnt += (c > 0u) ? 1u : 0u; mine = (j == x) ? c : mine; }
        if (sum == G) break;
        __builtin_amdgcn_s_sleep(1);
        if ((++sp & 255u) == 0u) { if (xb_ld(&bar[XB_TMO])) break; if (sp > XB_SPIN_CAP) { atomicAdd(&bar[XB_TMO], 1u); break; } }
    }
    nloc = mine > 0u ? mine : 1u; nx = cnt > 0u ? cnt : 1u;
}
DI void grid_barrier(unsigned* bar, volatile LAS unsigned* st, unsigned G, const int tid) {
    asm volatile("s_waitcnt vmcnt(0)" ::: "memory");
    __syncthreads();
    if (tid == 0) {
        __builtin_amdgcn_s_waitcnt(0);
        const unsigned x = xb_xcc_id();
        unsigned nloc = st[0], nx = st[1];
        if (nloc == 0u) { xcd_barrier_complete(bar, x, G, nloc, nx); st[0] = nloc; st[1] = nx; }
        const unsigned old = xb_add(&bar[XB_XSUB(x)], 1u);
        const unsigned gen = old / nloc;
        if (old + 1u == (gen + 1u) * nloc) {
            __builtin_amdgcn_fence(__ATOMIC_RELEASE, "agent");
            asm volatile("s_waitcnt vmcnt(0)" ::: "memory");
            const unsigned og = xb_add(&bar[XB_TOP], 1u);
            const unsigned tg = og / nx;
            if (og + 1u == (tg + 1u) * nx) xb_add(&bar[XB_TOPGEN], 1u);
            else XB_SPIN(xb_ld(&bar[XB_TOPGEN]) == tg, bar);
            __builtin_amdgcn_fence(__ATOMIC_ACQUIRE, "agent");
            xb_add(&bar[XB_XGEN(x)], 1u);
            asm volatile("s_waitcnt vmcnt(0)" ::: "memory");
        } else {
            XB_SPIN(xb_ld(&bar[XB_XGEN(x)]) == gen, bar);
            __builtin_amdgcn_fence(__ATOMIC_ACQUIRE, "agent");
            asm volatile("s_waitcnt vmcnt(0)" ::: "memory");
        }
    }
    __syncthreads();
}

#ifndef SINGLE_LAUNCH
#define SINGLE_LAUNCH 1
#endif

struct Args { const float* in[10]; float* out; unsigned char* ws; int ph_lo, ph_hi; };

template <int MODE> __global__ void __launch_bounds__(512, 2) mega(Args a) {
    extern __shared__ __attribute__((aligned(16))) unsigned char lds_raw[];
    cg::grid_group grid = cg::this_grid();
    LAS unsigned char* lds = (LAS unsigned char*)lds_raw;
    int tidl = threadIdx.x;
#define tid tidl
#define lane (tidl & 63)
#define wave (__builtin_amdgcn_readfirstlane(tidl >> 6))
    const int G = gridDim.x, c = blockIdx.x;
    const int NGW = G * 8, NGT = G * 512;
#define gw (cl * 8 + wave)
#define gt (cl * 512 + tid)
    size_t zl = 0; int cl = c;
#define GASP __attribute__((address_space(1)))
#define ARGP ((const __attribute__((address_space(4))) unsigned long long*)__builtin_amdgcn_kernarg_segment_ptr())
#define INP(i) ((const float*)(const GASP float*)ARGP[(i) + zl])
#define wsl ((unsigned char*)(GASP unsigned char*)ARGP[11 + zl])
#define OUTP ((float*)(GASP float*)ARGP[10 + zl])
#define PHASE_BEGIN() do { if (MODE != 1) asm volatile("" : "+s"(zl), "+s"(cl), "+v"(tidl) :: "memory"); } while (0)
#define PHASE_BEGIN1() do { if (MODE != 0) asm volatile("" : "+s"(zl), "+s"(cl), "+v"(tidl) :: "memory"); } while (0)
#define XIN INP(0)
#define fox_w_in INP(1)
#define fox_b_f INP(2)
#define fox_qg INP(3)
#define fox_kg INP(4)
#define fox_w_out INP(5)
#define ret_w_in INP(6)
#define ret_w_out INP(7)
#define ln_g INP(8)
#define ln_b INP(9)
#define cosT ((float*)(wsl + WS_COS))
#define sinT ((float*)(wsl + WS_SIN))
#define cosTT ((float*)(wsl + WS_COSTT))
#define sinTT ((float*)(wsl + WS_SINTT))
#define gpow ((float*)(wsl + WS_GPOW))
#define kdec ((float*)(wsl + WS_KDEC))
#define ginv ((float*)(wsl + WS_GINV))
#define LOGIT ((float*)(wsl + WS_LOGIT))
#define AUG ((float*)(wsl + WS_AUG))
#define WFT ((bf16*)(wsl + WS_WFT))
#define WFI ((bf16*)(wsl + WS_WFI))
#define WFO ((bf16*)(wsl + WS_WFO))
#define WRI ((bf16*)(wsl + WS_WRI))
#define WRO ((bf16*)(wsl + WS_WRO))
#define HB ((bf16*)(wsl + WS_HB))
#define H32 ((float*)(wsl + WS_H32))
#define RA ((bf16*)(wsl + WS_RA))
#define RB ((bf16*)(wsl + WS_RB))
#define RK ((bf16*)(wsl + WS_RK))
#define RKT ((bf16*)(wsl + WS_RKT))
#define RG ((bf16*)(wsl + WS_RG))
#define RU ((bf16*)(wsl + WS_RU))
#define PROJ RB
#define YF RA
#define ACAT RA
#define BCAT RB
#define YR RK
#define OB RU

    const int ph_lo = a.ph_lo, ph_hi = a.ph_hi;
    if (MODE != 1) { if (tidl < 2) ((volatile LAS unsigned*)(lds + 131072 + 1024))[tidl] = 0u;
        if (tidl == 0) (void)xb_add(&((unsigned*)(wsl + WS_BAR))[XB_XCNT(xb_xcc_id())], 1u);
        __syncthreads(); }
#ifndef NO_P0
    PHASE_BEGIN();
#ifndef REP_P0
#define REP_P0 1
#endif
    if (MODE != 1 && ph_lo == 0)
    for (int rep_ = 0; rep_ < REP_P0; ++rep_)
    {
        LAS float* scr = (LAS float*)(lds + wave * 16384);
        constexpr int I_FI = 32 * 256, I_FO = 32 * 64, I_RI = 32 * 384, I_RO = 64 * 64;
        constexpr int NITEMS = 2 * (I_FI + I_FO + I_RI + I_RO);
        auto decode = [&](int it) -> TrItem {
            int r = it; TrItem t;
            if (r < 2 * I_FI) { const int l = r / I_FI; r -= l * I_FI; t.W = fox_w_in + (size_t)l * 2048 * 8208; t.ldw = 8208; t.WT = WFI + (size_t)l * 8192 * 2048; t.ldt = 2048; t.k0 = (r / 256) * 64; t.n0 = (r % 256) * 32; return t; } r -= 2 * I_FI;
            if (r < 2 * I_FO) { const int l = r / I_FO; r -= l * I_FO; t.W = fox_w_out + (size_t)l * 2048 * 2048; t.ldw = 2048; t.WT = WFO + (size_t)l * 2048 * 2048; t.ldt = 2048; t.k0 = (r / 64) * 64; t.n0 = (r % 64) * 32; return t; } r -= 2 * I_FO;
            if (r < 2 * I_RI) { const int l = r / I_RI; r -= l * I_RI; t.W = ret_w_in + (size_t)l * 2048 * 12288; t.ldw = 12288; t.WT = WRI + (size_t)l * 12288 * 2048; t.ldt = 2048; t.k0 = (r / 384) * 64; t.n0 = (r % 384) * 32; return t; } r -= 2 * I_RI;
            { const int l = r / I_RO; r -= l * I_RO; t.W = ret_w_out + (size_t)l * 4096 * 2048; t.ldw = 2048; t.WT = WRO + (size_t)l * 2048 * 4096; t.ldt = 4096; t.k0 = (r / 64) * 64; t.n0 = (r % 64) * 32; return t; }
        };
        for (int it = gw; it < NITEMS; it += 2 * NGW) {
            const bool hasB = it + NGW < NITEMS;
            const TrItem ta = decode(it); const TrItem tb = decode(hasB ? it + NGW : it);
            float va[32], vb[32];
            tr_load(ta, lane, va); if (hasB) tr_load(tb, lane, vb);
            tr_store(ta, lane, va, scr); if (hasB) tr_store(tb, lane, vb, scr);
        }
        for (int i = gt; i < 2 * 16 * 2048; i += NGT) { const int l = i >> 15, n = (i >> 11) & 15, k = i & 2047; WFT[i] = (bf16)f2bf(fox_w_in[(size_t)l * 2048 * 8208 + (size_t)k * 8208 + 8192 + n]); }
        for (int i = gt; i < NTOK * DM / 4; i += 8 * NGT) {
            f32x4 v[8];
#pragma unroll
            for (int u = 0; u < 8; ++u) v[u] = ((const f32x4*)XIN)[i + u * NGT];
#pragma unroll
            for (int u = 0; u < 8; ++u) { u32x2 o; o.x = cvt_pk_bf16(v[u][0], v[u][1]); o.y = cvt_pk_bf16(v[u][2], v[u][3]); ((u32x2*)HB)[i + u * NGT] = o; } }
        for (int i = gt; i < 4096 * 128; i += NGT) { const int pos = i >> 7, fi = i & 127;
            const float inv = powf(10000.0f, -(float)(2 * fi) / 256.0f); const float ang = (float)pos * inv;
            const float cs = cosf(ang), sn = sinf(ang);
            cosT[i] = cs; sinT[i] = sn; cosTT[(size_t)fi * 4096 + pos] = cs; sinTT[(size_t)fi * 4096 + pos] = sn; }
        for (int i = gt; i < 8 * 260; i += NGT) { const int hh = i / 260, e = i % 260; const float lg = log1pf(-exp2f(-5.0f - (float)hh));
            gpow[i] = expf((float)e * lg);
            if (e < 256) { kdec[hh * 256 + e] = expf((float)(255 - e) * lg); ginv[hh * 256 + e] = expf(-(float)(e + 1) * lg); } }
    }
#endif
    if (MODE != 1 && ph_hi < 0) grid.sync();
    if (MODE != 1 && ph_lo == 0 && ph_hi > 1) grid_barrier((unsigned*)(wsl + WS_BAR), (volatile LAS unsigned*)(lds + 131072 + 1024), (unsigned)G, tidl);
#define RUN(id) (ph_lo <= (id) && (id) < ph_hi)
#define GBAR() grid_barrier((unsigned*)(wsl + WS_BAR), (volatile LAS unsigned*)(lds + 131072 + 1024), (unsigned)G, tidl)

#ifdef EXTRA_BARS
    for (int eb_ = 0; eb_ < EXTRA_BARS; ++eb_) GBAR();
#endif
#pragma unroll 1
    for (int l = 0; l < 2; ++l) {
        const int pb = 1 + 12 * l;
        const int li = 2 * l;
#ifndef NO_F1
        PHASE_BEGIN();
#ifndef REP_F1
#define REP_F1 1
#endif
        if (MODE != 1 && RUN(pb + 0)) for (int rep_ = 0; rep_ < REP_F1; ++rep_) {
        {
            const bf16* wf = WFT + (size_t)l * 16 * 2048; const int fr = lane & 15, fq = lane >> 4;
            for (int t2 = cl; t2 < 256; t2 += G) {
                const int t = t2 * 2 + (wave >> 2), kq = wave & 3;
                f32x4 acc = {0.f, 0.f, 0.f, 0.f};
                const bf16* ap = HB + (size_t)(t * 16 + fr) * 2048 + kq * 512 + fq * 8; const bf16* wp = wf + fr * 2048 + kq * 512 + fq * 8;
#pragma unroll
                for (int k = 0; k < 512; k += 32) { const bf16x8 av = *(const bf16x8*)(ap + k); const bf16x8 wv = *(const bf16x8*)(wp + k); acc = __builtin_amdgcn_mfma_f32_16x16x32_bf16(wv, av, acc, 0, 0, 0); }
                LAS f32x4* part = (LAS f32x4*)(lds + 131072 + 2048);
                part[wave * 64 + lane] = acc;
                __syncthreads();
                if (kq == 0) { const int w0 = wave; const f32x4 sum = (part[w0 * 64 + lane] + part[(w0 + 1) * 64 + lane]) + (part[(w0 + 2) * 64 + lane] + part[(w0 + 3) * 64 + lane]);
                    { const int tok = t * 16 + fr, bb = tok >> 12, ss = tok & 4095;
#pragma unroll
                      for (int j = 0; j < 4; ++j) { const int hh = fq * 4 + j; const float z = sum[j] + fox_b_f[l * 16 + hh];
                          LOGIT[((size_t)(bb * 16 + hh)) * 4096 + ss] = fminf(z, 0.f) - log1pf(expf(-fabsf(z))); } }
                }
                __syncthreads();
            }
            pg8::Gemm g{HB, WFI + (size_t)l * 8192 * 2048, 2048, 2048, 2048}; pg8::Sched S; S.init_reg(32, 32, 2048, 2048, G, cl);
            pg8::EpiFoxIn E{PROJ, fox_qg + l * 128, fox_kg + l * 128, lds + 131072 + 2048};
            pg8::gemm_phase<pg8::EpiFoxIn>(lds, g, S, E, tidl);
        }
        }
#endif
#ifndef NO_F2
        PHASE_BEGIN();
        if (false && MODE != 1 && RUN(pb + 1)) {
        {
            if (cl < 32) {
                if (tid == 0) { unsigned* cp = (unsigned*)(wsl + WS_BAR + 49152) + l * 64; unsigned sp = 0;
                    while (__hip_atomic_load(cp, __ATOMIC_RELAXED, __HIP_MEMORY_SCOPE_AGENT) < 512u) { __builtin_amdgcn_s_sleep(2); if (++sp > (1u << 22)) break; }
                    __builtin_amdgcn_fence(__ATOMIC_ACQUIRE, "agent"); asm volatile("s_waitcnt vmcnt(0)" ::: "memory"); }
                __syncthreads();
            }
            for (int bh = cl; bh < 32; bh += G) {
                float v[8]; float run = 0.f;
                { const f32x4 a0 = *(const f32x4*)(LOGIT + (size_t)bh * 4096 + tid * 8), a1 = *(const f32x4*)(LOGIT + (size_t)bh * 4096 + tid * 8 + 4);
#pragma unroll
                  for (int e = 0; e < 4; ++e) { run += a0[e]; v[e] = run; }
#pragma unroll
                  for (int e = 0; e < 4; ++e) { run += a1[e]; v[4 + e] = run; } }
                float incl = run;
#pragma unroll
                for (int o = 1; o < 64; o <<= 1) { const float t = __shfl_up(incl, o); if (lane >= o) incl += t; }
                LAS float* wt = (LAS float*)lds;
                __syncthreads();
                if (lane == 63) wt[wave] = incl;
                __syncthreads();
                float base = incl - run;
                for (int w = 0; w < wave; ++w) base += wt[w];
                { f32x4 o0, o1;
#pragma unroll
                  for (int e = 0; e < 4; ++e) { o0[e] = -(base + v[e]) * 11.313708498984761f; o1[e] = -(base + v[4 + e]) * 11.313708498984761f; }
                  *(f32x4*)(AUG + (size_t)bh * 4096 + tid * 8) = o0; *(f32x4*)(AUG + (size_t)bh * 4096 + tid * 8 + 4) = o1; }
                __syncthreads();
            }
        }
        }
#endif
        if (RUN(pb + 1) && RUN(pb + 2)) GBAR();
#if !defined(NO_F3)
        PHASE_BEGIN1();
#ifndef REP_F3
#define REP_F3 1
#endif
        if (MODE != 0 && RUN(pb + 2)) for (int rep_ = 0; rep_ < REP_F3; ++rep_) {
        fa::attn_phase((char*)lds_raw, PROJ, LOGIT, YF, G, cl, tidl);
        }
#endif
        if (RUN(pb + 2) && RUN(pb + 3)) GBAR();
#ifndef NO_F4
        PHASE_BEGIN();
        if (MODE != 1 && RUN(pb + 3)) {
        {
            pg8::Gemm g{YF, WFO + (size_t)l * 2048 * 2048, 2048, 2048, 2048}; pg8::Sched S; S.init_reg(32, 8, 2048, 2048, G, cl);
            pg8::EpiLnFused E{l == 0 ? XIN : (RESID_BF16 ? (const float*)nullptr : H32), RESID_BF16 ? (float*)nullptr : H32, HB, ln_g + li * 2048, ln_b + li * 2048, 1.6817928305074290f,
                (unsigned long long*)(wsl + WS_XSLOT) + (size_t)(2 * l) * 65536, (unsigned*)(wsl + WS_LNCNT) + (2 * l) * 2048, lds + 131072 + 2048};
            pg8::gemm_phase<pg8::EpiLnFused>(lds, g, S, E, tidl);
        }
        }
#endif
        if (RUN(pb + 3) && RUN(pb + 4)) GBAR();
#ifndef NO_F5
        PHASE_BEGIN();
        if (false && MODE != 1 && RUN(pb + 4)) {
        {
            const float* gn = ln_g + li * 2048; const float* bt = ln_b + li * 2048;
            for (int r = gw; r < NTOK; r += NGW) {
                float* row = H32 + (size_t)r * 2048; f32x4 v[8]; float s = 0.f;
#pragma unroll
                for (int j = 0; j < 8; ++j) { v[j] = *(const f32x4*)(row + (j * 64 + lane) * 4); s += (v[j][0] + v[j][1]) + (v[j][2] + v[j][3]); }
                const float mean = wave_sum(s) * (1.f / 2048.f); float s2 = 0.f;
#pragma unroll
                for (int j = 0; j < 8; ++j) { v[j] = v[j] - mean; s2 += (v[j][0] * v[j][0] + v[j][1] * v[j][1]) + (v[j][2] * v[j][2] + v[j][3] * v[j][3]); }
                const float rstd = rsqrtf(wave_sum(s2) * (1.f / 2048.f) + 1e-5f);
#pragma unroll
                for (int j = 0; j < 8; ++j) { const int cc = (j * 64 + lane) * 4; const f32x4 y = v[j] * rstd * *(const f32x4*)(gn + cc) + *(const f32x4*)(bt + cc);
                    *(f32x4*)(row + cc) = y; u32x2 o; o.x = cvt_pk_bf16(y[0], y[1]); o.y = cvt_pk_bf16(y[2], y[3]); *(u32x2*)(HB + (size_t)r * 2048 + cc) = o; }
            }
        }
        }
#endif

        const int lj = 2 * l + 1;
#ifndef NO_R1
        PHASE_BEGIN();
#ifndef REP_R1
#define REP_R1 1
#endif
        if (MODE != 1 && RUN(pb + 5)) for (int rep_ = 0; rep_ < REP_R1; ++rep_) {
        {
            pg8::Gemm g{HB, WRI + (size_t)l * 12288 * 2048, 2048, 2048, 2048}; pg8::Sched S; S.init_reg(32, 32, 2048, 2048, G, cl, 16, 16);
            pg8::EpiRetNat E{ACAT, RK, RG, cosT, sinT, gpow, RKT, kdec};
            pg8::gemm_phase<pg8::EpiRetNat>(lds, g, S, E, tidl);
        }
        PHASE_BEGIN();
        {
            pg8::Gemm g{WRI + (size_t)l * 12288 * 2048 + (size_t)4096 * 2048, HB, 2048, 2048, 2048}; pg8::Sched S; S.init_reg(16, 32, 2048, 2048, G, cl);
            pg8::EpiRetSwap E{BCAT};
            pg8::gemm_phase<pg8::EpiRetSwap>(lds, g, S, E, tidl);
        }
        }
#endif
        if (RUN(pb + 5) && RUN(pb + 6)) GBAR();
#ifndef NO_R2
        PHASE_BEGIN();
#ifndef REP_R2
#define REP_R2 1
#endif
        if (MODE != 1 && RUN(pb + 6)) for (int rep_ = 0; rep_ < REP_R2; ++rep_) {
        {
            pg8::Gemm g{BCAT, RKT, 512, 256, 256}; pg8::Sched S; S.init_bat(256, 2, 512u * 512u * 2u, 256u * 512u * 2u, 256u * 256u * 2u, 0u, G, cl);
            pg8::EpiU E{RU};
            pg8::gemm_phase<pg8::EpiU>(lds, g, S, E, tidl);
        }
#ifndef NO_R2B
        PHASE_BEGIN();
        {
            pg8::Gemm g{ACAT + 256, RK, 512, 256, 256}; pg8::Sched S; S.init_bat(256, 1, 256u * 512u * 2u, 0u, 256u * 256u * 2u, 0u, G, cl);
            pg8::EpiT E{ACAT, ginv};
            pg8::gemm_phase<pg8::EpiT>(lds, g, S, E, tidl);
        }
#endif
        }
#endif
        if (RUN(pb + 6) && RUN(pb + 7)) GBAR();
#ifndef NO_R3
        PHASE_BEGIN();
#ifndef REP_R3
#define REP_R3 1
#endif
        if (MODE != 1 && RUN(pb + 7)) for (int rep_ = 0; rep_ < REP_R3; ++rep_) {
        for (int gi = gt; gi < 16 * 16384; gi += NGT) {
            const int bh = gi >> 14, idx = gi & 16383, v = idx >> 5, d8 = (idx & 31) * 8, hh = bh & 7; const float cd = gpow[hh * 260 + 256];
            float R[8] = {0.f, 0.f, 0.f, 0.f, 0.f, 0.f, 0.f, 0.f};
            u32x4 un[15];
#pragma unroll
            for (int n = 0; n < 15; ++n) un[n] = *(const u32x4*)(RU + ((size_t)(bh * 16 + n) * 512 + v) * 256 + d8);
#pragma unroll
            for (int n = 0; n < 16; ++n) {
                u32x4 o; o.x = cvt_pk_bf16(R[0], R[1]); o.y = cvt_pk_bf16(R[2], R[3]); o.z = cvt_pk_bf16(R[4], R[5]); o.w = cvt_pk_bf16(R[6], R[7]);
                *(u32x4*)(BCAT + ((size_t)(bh * 16 + n) * 512 + v) * 512 + 256 + d8) = o;
                if (n < 15) { const u32x4 u = un[n];
                    R[0] = cd * R[0] + bf_lo(u.x); R[1] = cd * R[1] + bf_hi(u.x); R[2] = cd * R[2] + bf_lo(u.y); R[3] = cd * R[3] + bf_hi(u.y);
                    R[4] = cd * R[4] + bf_lo(u.z); R[5] = cd * R[5] + bf_hi(u.z); R[6] = cd * R[6] + bf_lo(u.w); R[7] = cd * R[7] + bf_hi(u.w); }
            }
        }
        }
#endif
        if (RUN(pb + 7) && RUN(pb + 8)) GBAR();
#ifndef NO_R4
        PHASE_BEGIN();
#ifndef REP_R4
#define REP_R4 1
#endif
        if (MODE != 1 && RUN(pb + 8)) for (int rep_ = 0; rep_ < REP_R4; ++rep_) {
        {
            pg8::Gemm g{ACAT, BCAT, 512, 512, 512}; pg8::Sched S; S.init_bat(256, 2, 256u * 512u * 2u, 0u, 512u * 512u * 2u, 256u * 512u * 2u, G, cl);
            pg8::EpiOGn E{YR, RG, (unsigned long long*)(wsl + WS_GSLOT), (unsigned*)(wsl + WS_GNCNT) + l * 256 * 64, lds + 131072 + 2048};
            pg8::gemm_phase<pg8::EpiOGn>(lds, g, S, E, tidl);
        }
        }
#endif
        if (RUN(pb + 8) && RUN(pb + 9)) GBAR();
#ifndef NO_R5
        PHASE_BEGIN();
#ifndef REP_R5
#define REP_R5 1
#endif
        if (false && MODE != 1 && RUN(pb + 9)) for (int rep_ = 0; rep_ < REP_R5; ++rep_) {
        for (int t = gw; t < NTOK; t += NGW) {
#pragma unroll 2
            for (int hh = 0; hh < 8; ++hh) {
                const size_t off = (size_t)t * 4096 + hh * 512 + lane * 8;
                const u32x4 raw = *(const u32x4*)(OB + off); const u32x4 gr = *(const u32x4*)(RG + off);
                float v[8] = {bf_lo(raw.x), bf_hi(raw.x), bf_lo(raw.y), bf_hi(raw.y), bf_lo(raw.z), bf_hi(raw.z), bf_lo(raw.w), bf_hi(raw.w)};
                float gv[8] = {bf_lo(gr.x), bf_hi(gr.x), bf_lo(gr.y), bf_hi(gr.y), bf_lo(gr.z), bf_hi(gr.z), bf_lo(gr.w), bf_hi(gr.w)};
                float s = 0.f;
#pragma unroll
                for (int e = 0; e < 8; ++e) s += v[e];
                const float mean = wave_sum(s) * (1.f / 512.f); float s2 = 0.f;
#pragma unroll
                for (int e = 0; e < 8; ++e) { v[e] -= mean; s2 += v[e] * v[e]; }
                const float rstd = rsqrtf(wave_sum(s2) * (1.f / 512.f) + 1e-6f);
                float y[8];
#pragma unroll
                for (int e = 0; e < 8; ++e) y[e] = v[e] * rstd * gv[e] / (1.f + __expf(-gv[e]));
                u32x4 o; o.x = cvt_pk_bf16(y[0], y[1]); o.y = cvt_pk_bf16(y[2], y[3]); o.z = cvt_pk_bf16(y[4], y[5]); o.w = cvt_pk_bf16(y[6], y[7]);
                *(u32x4*)(YR + off) = o;
            }
        }
        }
#endif
#ifndef NO_R6
        PHASE_BEGIN();
        if (MODE != 1 && RUN(pb + 10)) {
        {
            pg8::Gemm g{YR, WRO + (size_t)l * 2048 * 4096, 4096, 4096, 4096}; pg8::Sched S; S.init_reg(32, 8, 4096, 4096, G, cl);
            pg8::EpiLnFused E{RESID_BF16 ? (const float*)nullptr : H32, (l == 1) ? OUTP : (RESID_BF16 ? (float*)nullptr : H32), HB, ln_g + lj * 2048, ln_b + lj * 2048, 1.6817928305074290f,
                (unsigned long long*)(wsl + WS_XSLOT) + (size_t)(2 * l + 1) * 65536, (unsigned*)(wsl + WS_LNCNT) + (2 * l + 1) * 2048, lds + 131072 + 2048};
            pg8::gemm_phase<pg8::EpiLnFused>(lds, g, S, E, tidl);
        }
        }
#endif
        if (l == 0 && RUN(pb + 10) && RUN(pb + 11)) GBAR();
#ifndef NO_R7
        PHASE_BEGIN();
        if (false && MODE != 1 && RUN(pb + 11)) {
        {
            const float* gn = ln_g + lj * 2048; const float* bt = ln_b + lj * 2048; float* dstf = (l == 1) ? OUTP : H32;
            for (int r = gw; r < NTOK; r += NGW) {
                const float* row = H32 + (size_t)r * 2048; f32x4 v[8]; float s = 0.f;
#pragma unroll
                for (int j = 0; j < 8; ++j) { v[j] = *(const f32x4*)(row + (j * 64 + lane) * 4); s += (v[j][0] + v[j][1]) + (v[j][2] + v[j][3]); }
                const float mean = wave_sum(s) * (1.f / 2048.f); float s2 = 0.f;
#pragma unroll
                for (int j = 0; j < 8; ++j) { v[j] = v[j] - mean; s2 += (v[j][0] * v[j][0] + v[j][1] * v[j][1]) + (v[j][2] * v[j][2] + v[j][3] * v[j][3]); }
                const float rstd = rsqrtf(wave_sum(s2) * (1.f / 2048.f) + 1e-5f);
#pragma unroll
                for (int j = 0; j < 8; ++j) { const int cc = (j * 64 + lane) * 4; const f32x4 y = v[j] * rstd * *(const f32x4*)(gn + cc) + *(const f32x4*)(bt + cc);
                    *(f32x4*)(dstf + (size_t)r * 2048 + cc) = y; u32x2 o; o.x = cvt_pk_bf16(y[0], y[1]); o.y = cvt_pk_bf16(y[2], y[3]); *(u32x2*)(HB + (size_t)r * 2048 + cc) = o; }
            }
        }
        }
#endif
    }
}


extern "C" void kernel_launch(void* const* d_in, const int* in_sizes, int n_in, void* d_out, int out_size, void* d_ws, size_t ws_size, hipStream_t stream) {
    static int grid = 0;
    if (grid == 0) {
        if (n_in != 10 || ws_size < WS_END) { fprintf(stderr, "kernel_launch: unexpected n_in %d / ws_size %zu (need %zu)\n", n_in, ws_size, (size_t)WS_END); grid = -1; return; }
        int dev = 0, cus = 0, per_cu = 0;
        hipGetDevice(&dev); hipDeviceGetAttribute(&cus, hipDeviceAttributeMultiprocessorCount, dev);
#if SINGLE_LAUNCH
        hipFuncSetAttribute((const void*)mega<2>, hipFuncAttributeMaxDynamicSharedMemorySize, LDS_BYTES);
#else
        hipFuncSetAttribute((const void*)mega<0>, hipFuncAttributeMaxDynamicSharedMemorySize, LDS_BYTES);
        hipFuncSetAttribute((const void*)mega<1>, hipFuncAttributeMaxDynamicSharedMemorySize, LDS_BYTES);
#endif
        hipOccupancyMaxActiveBlocksPerMultiprocessor(&per_cu, (const void*)mega<SINGLE_LAUNCH ? 2 : 0>, 512, LDS_BYTES);
        if (per_cu < 1) { fprintf(stderr, "kernel_launch: occupancy query says %d blocks per CU\n", per_cu); per_cu = 1; }
        grid = cus;
    }
    if (grid < 0) return;
    Args a{};
    for (int i = 0; i < 10; ++i) a.in[i] = (const float*)d_in[i];
    a.out = (float*)d_out; a.ws = (unsigned char*)d_ws;
#if SINGLE_LAUNCH
    const int cuts[2] = {0, 25}; const int nl = 1;
#else
    const int cuts[4] = {0, 3, 15, 25}; const int nl = 3;
#endif
    for (int li = 0; li < nl; ++li) {
        if (hipMemsetAsync((char*)d_ws + WS_BAR, 0, 65536 + 2 * 256 * 256, stream) != hipSuccess) { fprintf(stderr, "memset failed\n"); return; }
        a.ph_lo = cuts[li] + (li > 0 ? 1 : 0); a.ph_hi = cuts[li + 1];
        void* args[] = {&a};
#if SINGLE_LAUNCH
        hipError_t e = hipLaunchCooperativeKernel((const void*)mega<2>, dim3(grid), dim3(512), args, LDS_BYTES, stream);
#else
        hipError_t e = hipLaunchCooperativeKernel((const void*)mega<0>, dim3(grid), dim3(512), args, LDS_BYTES, stream);
#endif
        if (e != hipSuccess) { fprintf(stderr, "cooperative launch failed: %s (grid %d)\n", hipGetErrorString(e), grid); return; }
#if !SINGLE_LAUNCH
        if (li + 1 < nl) { Args b = a; b.ph_lo = cuts[li + 1]; b.ph_hi = cuts[li + 1] + 1; hipLaunchKernelGGL(mega<1>, dim3(grid), dim3(512), LDS_BYTES, stream, b); }
#endif
    }
}
```

```cpp
#include <hip/hip_runtime.h>
#include <hip/hip_cooperative_groups.h>
#include <cstdio>
#include <cstdint>
namespace cg = cooperative_groups;
#ifndef RESID_BF16
#define RESID_BF16 1
#endif

#define DI __device__ __forceinline__
typedef unsigned short bf16;
typedef short bf16x8 __attribute__((ext_vector_type(8)));
typedef short s16x4 __attribute__((ext_vector_type(4)));
typedef float f32x4 __attribute__((ext_vector_type(4)));
typedef float f32x16 __attribute__((ext_vector_type(16)));
typedef unsigned u32x4 __attribute__((ext_vector_type(4)));
typedef unsigned u32x2 __attribute__((ext_vector_type(2)));

DI unsigned cvt_pk_bf16(float lo, float hi) { unsigned r; asm volatile("v_cvt_pk_bf16_f32 %0, %1, %2" : "=v"(r) : "v"(lo), "v"(hi)); return r; }
DI float bf_lo(unsigned w) { return __uint_as_float(w << 16); }
DI float bf_hi(unsigned w) { return __uint_as_float(w & 0xffff0000u); }
DI float bf2f(bf16 b) { return __uint_as_float(((unsigned)b) << 16); }
DI unsigned f2bf(float f) { unsigned u = __float_as_uint(f); return (u + 0x7fffu + ((u >> 16) & 1u)) >> 16; }
DI float wave_sum(float v) {
#pragma unroll
    for (int o = 1; o < 64; o <<= 1) v += __shfl_xor(v, o);
    return v;
}

namespace pg8 {
#define PG8_LAS __attribute__((address_space(3)))
constexpr int BM = 256, BK = 64, HALF = 128, HTB = HALF * BK * 2, STAGE_BYTES = 8 * HTB, NXCD = 8, WGM = 8;
DI int lds_byte(int r, int c) { const int st = (r >> 4) * 2 + (c >> 5), rr = r & 15, cc = c & 31, ob = rr * 64 + cc * 2; return st * 1024 + (ob ^ (((ob >> 9) & 1) << 5)); }
DI void stage_rc(int b, int& R, int& C) { const int st = b / 1024, sb = b % 1024, swz = sb ^ (((sb >> 9) & 1) << 5); R = (st >> 1) * 16 + swz / 64; C = (st & 1) * 32 + (swz % 64) / 2; }
DI int perm32(int rho) { const int n = rho >> 4, i = rho & 15; return 8 * (i >> 2) + 4 * n + (i & 3); }

struct Unit { int pm, pn; unsigned aoff, boff; };
struct Gemm { const bf16* A; const bf16* Bt; int lda, ldb, K; };

struct Sched {
    int mode;
    int nM, nN, nwg, G, c;
    int bsplit, bskip;
    unsigned atile, btile;
    int nj; unsigned ab, aj, bb, bj;
    DI void init_reg(int nM_, int nN_, int lda, int ldb, int G_, int c_, int bsplit_ = 1 << 30, int bskip_ = 0) {
        mode = 0; nM = nM_; nN = nN_; nwg = nM * nN; G = G_; c = c_; bsplit = bsplit_; bskip = bskip_; atile = 256u * lda * 2u; btile = 256u * ldb * 2u; nj = 1; ab = aj = bb = bj = 0; }
    DI void init_bat(int nbatch, int nj_, unsigned ab_, unsigned aj_, unsigned bb_, unsigned bj_, int G_, int c_) {
        mode = 1; nM = nbatch; nN = nj_; nwg = nbatch * nj_; G = G_; c = c_; bsplit = 1 << 30; bskip = 0; atile = btile = 0; nj = nj_; ab = ab_; aj = aj_; bb = bb_; bj = bj_; }
    DI bool next(int i, Unit& u) const {
        const int L = i * G + c; if (L >= nwg) return false;
        if (mode == 0) {
            int wgid = L; { const int q = nwg / NXCD, r = nwg % NXCD, xcd = wgid % NXCD, off = wgid / NXCD; wgid = (xcd < r ? xcd * (q + 1) : r * (q + 1) + (xcd - r) * q) + off; }
            const int nig = WGM * nN, gid = wgid / nig, fm = gid * WGM, gsz = (nM - fm) < WGM ? (nM - fm) : WGM;
            u.pm = fm + ((wgid % nig) % gsz); u.pn = (wgid % nig) / gsz;
            const int pb = u.pn < bsplit ? u.pn : u.pn + bskip;
            u.aoff = (unsigned)u.pm * atile; u.boff = (unsigned)pb * btile;
        } else {
            int batch, j;
            if (nj == 2) { const int g16 = L >> 4, r16 = L & 15; j = r16 >> 3; batch = g16 * 8 + (r16 & 7); }
            else { batch = L / nj; j = L - batch * nj; }
            u.pm = batch; u.pn = j;
            u.aoff = (unsigned)batch * ab + (unsigned)j * aj; u.boff = (unsigned)batch * bb + (unsigned)j * bj;
        }
        return true;
    }
};

DI u32x4 pack8(const f32x4& v0, const f32x4& v1) { u32x4 w; w.x = cvt_pk_bf16(v0[0], v0[1]); w.y = cvt_pk_bf16(v0[2], v0[3]); w.z = cvt_pk_bf16(v1[0], v1[1]); w.w = cvt_pk_bf16(v1[2], v1[3]); return w; }

struct EpiBf16 {
    static constexpr bool PERM = true;
    bf16* O; int ldc;
    DI void operator()(const f32x4 (&acc)[2][2][4][2], const Unit& u, int wr, int wc, int fr, int fq) const {
        const int row0 = u.pm * BM + wr * 64 + fr, col0 = u.pn * BM + wc * 32 + 8 * fq;
#pragma unroll
        for (int ai = 0; ai < 2; ++ai)
#pragma unroll
            for (int m = 0; m < 4; ++m) { int rr = row0 + ai * HALF + m * 16; asm volatile("" : "+v"(rr)); bf16* rowp = O + (size_t)rr * ldc + col0;
#pragma unroll
                for (int bj = 0; bj < 2; ++bj) *(u32x4*)(rowp + bj * HALF) = pack8(acc[ai][bj][m][0], acc[ai][bj][m][1]); }
    }
};
struct EpiResid {
    static constexpr bool PERM = false;
    const float* resid; float* out; int ldc; float alpha;
    DI void operator()(const f32x4 (&acc)[2][2][4][2], const Unit& u, int wr, int wc, int fr, int fq) const {
        const int row0 = u.pm * BM + wr * 64 + fr, col0 = u.pn * BM + wc * 32 + 4 * fq;
#pragma unroll
        for (int ai = 0; ai < 2; ++ai)
#pragma unroll
            for (int m = 0; m < 4; ++m) { int rr = row0 + ai * HALF + m * 16; asm volatile("" : "+v"(rr)); const size_t off = (size_t)rr * ldc + col0;
#pragma unroll
                for (int bj = 0; bj < 2; ++bj)
#pragma unroll
                    for (int n = 0; n < 2; ++n) { const f32x4 rs = *(const f32x4*)(resid + off + bj * HALF + n * 16); *(f32x4*)(out + off + bj * HALF + n * 16) = rs * alpha + acc[ai][bj][m][n]; } }
    }
};
struct EpiLnFused {
    static constexpr bool PERM = false;
    const float* resid; float* outf; bf16* outb; const float* gn; const float* bt; float alpha;
    unsigned long long* xslots; unsigned* cnt; PG8_LAS unsigned char* xl;
    DI void operator()(f32x4 (&acc)[2][2][4][2], const Unit& u, int wr, int wc, int fr, int fq) const {
        const int row0 = u.pm * BM + wr * 64 + fr, col0 = u.pn * BM + wc * 32 + 4 * fq;
        const int tid = (wr * 4 + wc) * 64 + fq * 16 + fr;
        PG8_LAS float* P = (PG8_LAS float*)xl;
        PG8_LAS float* S = (PG8_LAS float*)(xl + 8192);
        f32x4 rsb[2][2][2];
#define RLOAD(g_, sl_) do { int rr_ = row0 + ((g_) >> 2) * HALF + ((g_) & 3) * 16; asm volatile("" : "+v"(rr_)); const size_t off_ = (size_t)rr_ * 2048 + col0; \
            _Pragma("unroll") for (int bj_ = 0; bj_ < 2; ++bj_) _Pragma("unroll") for (int n_ = 0; n_ < 2; ++n_) { \
                if (resid) rsb[sl_][bj_][n_] = *(const f32x4*)(resid + off_ + bj_ * HALF + n_ * 16); \
                else { const u32x2 rb_ = *(const u32x2*)(outb + off_ + bj_ * HALF + n_ * 16); rsb[sl_][bj_][n_] = (f32x4){bf_lo(rb_.x), bf_hi(rb_.x), bf_lo(rb_.y), bf_hi(rb_.y)}; } } } while (0)
        RLOAD(0, 0);
#pragma unroll
        for (int ai = 0; ai < 2; ++ai)
#pragma unroll
            for (int m = 0; m < 4; ++m) { const int gi = ai * 4 + m, sl = gi & 1;
                if (gi < 7) RLOAD(gi + 1, (gi + 1) & 1);
                int rr = row0 + ai * HALF + m * 16; asm volatile("" : "+v"(rr));
                float sm = 0.f, sq = 0.f;
#pragma unroll
                for (int bj = 0; bj < 2; ++bj)
#pragma unroll
                    for (int n = 0; n < 2; ++n) { const f32x4 t = rsb[sl][bj][n] * alpha + acc[ai][bj][m][n]; acc[ai][bj][m][n] = t;
                        sm += (t[0] + t[1]) + (t[2] + t[3]); sq += (t[0] * t[0] + t[1] * t[1]) + (t[2] * t[2] + t[3] * t[3]); }
                sm += __shfl_xor(sm, 16); sm += __shfl_xor(sm, 32); sq += __shfl_xor(sq, 16); sq += __shfl_xor(sq, 32);
                if (fq == 0) { const int rl = (rr - u.pm * BM); P[(rl * 4 + wc) * 2] = sm; P[(rl * 4 + wc) * 2 + 1] = sq; }
                asm volatile("" ::: "memory"); }
#undef RLOAD
        __syncthreads();
        if (tid < 256) { float sm = 0.f, sq = 0.f;
#pragma unroll
            for (int w = 0; w < 4; ++w) { sm += P[(tid * 4 + w) * 2]; sq += P[(tid * 4 + w) * 2 + 1]; }
            const unsigned long long v = ((unsigned long long)__float_as_uint(sq) << 32) | (unsigned long long)__float_as_uint(sm);
            __hip_atomic_store(xslots + ((size_t)(u.pm * 256 + tid) * 8 + u.pn), v, __ATOMIC_RELAXED, __HIP_MEMORY_SCOPE_AGENT); }
        asm volatile("s_waitcnt vmcnt(0)" ::: "memory");
        __syncthreads();
        if (tid == 0) { unsigned* cp = cnt + 64 * u.pm; __hip_atomic_fetch_add(cp, 1u, __ATOMIC_RELAXED, __HIP_MEMORY_SCOPE_AGENT);
            unsigned sp = 0; while (__hip_atomic_load(cp, __ATOMIC_RELAXED, __HIP_MEMORY_SCOPE_AGENT) < 8u) { __builtin_amdgcn_s_sleep(1); if (++sp > (1u << 22)) break; } }
        __syncthreads();
        if (tid < 256) { float sm = 0.f, sq = 0.f;
#pragma unroll
            for (int w = 0; w < 8; ++w) { const unsigned long long v = __hip_atomic_load(xslots + ((size_t)(u.pm * 256 + tid) * 8 + w), __ATOMIC_RELAXED, __HIP_MEMORY_SCOPE_AGENT);
                sm += __uint_as_float((unsigned)v); sq += __uint_as_float((unsigned)(v >> 32)); }
            const float mean = sm * (1.f / 2048.f); const float var = fmaxf(sq * (1.f / 2048.f) - mean * mean, 0.f);
            S[tid * 2] = mean; S[tid * 2 + 1] = rsqrtf(var + 1e-5f); }
        f32x4 g4[2][2], b4[2][2];
#pragma unroll
        for (int bj = 0; bj < 2; ++bj)
#pragma unroll
            for (int n = 0; n < 2; ++n) { g4[bj][n] = *(const f32x4*)(gn + col0 + bj * HALF + n * 16); b4[bj][n] = *(const f32x4*)(bt + col0 + bj * HALF + n * 16); }
        __syncthreads();
#pragma unroll
        for (int ai = 0; ai < 2; ++ai)
#pragma unroll
            for (int m = 0; m < 4; ++m) { int rr = row0 + ai * HALF + m * 16; asm volatile("" : "+v"(rr)); const size_t off = (size_t)rr * 2048 + col0;
                const int rl = rr - u.pm * BM; const float mean = S[rl * 2], rstd = S[rl * 2 + 1];
#pragma unroll
                for (int bj = 0; bj < 2; ++bj)
#pragma unroll
                    for (int n = 0; n < 2; ++n) { const f32x4 y = (acc[ai][bj][m][n] - mean) * rstd * g4[bj][n] + b4[bj][n];
                        if (outf) *(f32x4*)(outf + off + bj * HALF + n * 16) = y; if (!outf || !RESID_BF16) { u32x2 o; o.x = cvt_pk_bf16(y[0], y[1]); o.y = cvt_pk_bf16(y[2], y[3]); *(u32x2*)(outb + off + bj * HALF + n * 16) = o; } }
                asm volatile("" ::: "memory"); }
    }
};
struct EpiOGn {
    static constexpr bool PERM = true;
    bf16* Y; const bf16* GATE; unsigned long long* xslots; unsigned* cnt; PG8_LAS unsigned char* xl;
    DI void operator()(f32x4 (&acc)[2][2][4][2], const Unit& u, int wr, int wc, int fr, int fq) const {
        const int batch = u.pm, b = batch >> 7, hh = (batch >> 4) & 7, n = batch & 15;
        const int tid = (wr * 4 + wc) * 64 + fq * 16 + fr;
        PG8_LAS float* P = (PG8_LAS float*)xl; PG8_LAS float* S = (PG8_LAS float*)(xl + 8192);
        u32x4 gpl[2][2];
#define GLOADG(g_, sl_) do { int rl_ = ((g_) >> 2) * HALF + wr * 64 + ((g_) & 3) * 16 + fr; asm volatile("" : "+v"(rl_)); \
            const size_t off_ = ((size_t)b * 4096 + n * 256 + rl_) * 4096 + hh * 512 + u.pn * 256 + wc * 32 + 8 * fq; \
            gpl[sl_][0] = *(const u32x4*)(GATE + off_); gpl[sl_][1] = *(const u32x4*)(GATE + off_ + HALF); } while (0)
        GLOADG(0, 0);
#pragma unroll
        for (int ai = 0; ai < 2; ++ai)
#pragma unroll
            for (int m = 0; m < 4; ++m) { float sm = 0.f, sq = 0.f;
#pragma unroll
                for (int bj = 0; bj < 2; ++bj)
#pragma unroll
                    for (int n2 = 0; n2 < 2; ++n2) { const f32x4 t = acc[ai][bj][m][n2]; sm += (t[0] + t[1]) + (t[2] + t[3]); sq += (t[0] * t[0] + t[1] * t[1]) + (t[2] * t[2] + t[3] * t[3]); }
                sm += __shfl_xor(sm, 16); sm += __shfl_xor(sm, 32); sq += __shfl_xor(sq, 16); sq += __shfl_xor(sq, 32);
                if (fq == 0) { const int rl = ai * HALF + wr * 64 + m * 16 + fr; P[(rl * 4 + wc) * 2] = sm; P[(rl * 4 + wc) * 2 + 1] = sq; } }
        __syncthreads();
        if (tid < 256) { float sm = 0.f, sq = 0.f;
#pragma unroll
            for (int w = 0; w < 4; ++w) { sm += P[(tid * 4 + w) * 2]; sq += P[(tid * 4 + w) * 2 + 1]; }
            const unsigned long long v = ((unsigned long long)__float_as_uint(sq) << 32) | (unsigned long long)__float_as_uint(sm);
            __hip_atomic_store(xslots + ((size_t)(batch * 256 + tid) * 2 + u.pn), v, __ATOMIC_RELAXED, __HIP_MEMORY_SCOPE_AGENT); }
        asm volatile("s_waitcnt vmcnt(0)" ::: "memory");
        __syncthreads();
        if (tid == 0) { unsigned* cp = cnt + 64 * batch; __hip_atomic_fetch_add(cp, 1u, __ATOMIC_RELAXED, __HIP_MEMORY_SCOPE_AGENT);
            unsigned sp = 0; while (__hip_atomic_load(cp, __ATOMIC_RELAXED, __HIP_MEMORY_SCOPE_AGENT) < 2u) { __builtin_amdgcn_s_sleep(1); if (++sp > (1u << 22)) break; } }
        __syncthreads();
        if (tid < 256) { float sm = 0.f, sq = 0.f;
#pragma unroll
            for (int w = 0; w < 2; ++w) { const unsigned long long v = __hip_atomic_load(xslots + ((size_t)(batch * 256 + tid) * 2 + w), __ATOMIC_RELAXED, __HIP_MEMORY_SCOPE_AGENT);
                sm += __uint_as_float((unsigned)v); sq += __uint_as_float((unsigned)(v >> 32)); }
            const float mean = sm * (1.f / 512.f); const float var = fmaxf(sq * (1.f / 512.f) - mean * mean, 0.f);
            S[tid * 2] = mean; S[tid * 2 + 1] = rsqrtf(var + 1e-6f); }
        __syncthreads();
#pragma unroll
        for (int ai = 0; ai < 2; ++ai)
#pragma unroll
            for (int m = 0; m < 4; ++m) { const int gi = ai * 4 + m, sl = gi & 1;
                if (gi < 7) GLOADG(gi + 1, (gi + 1) & 1);
                int rl = ai * HALF + wr * 64 + m * 16 + fr; asm volatile("" : "+v"(rl));
                const float mean = S[rl * 2], rstd = S[rl * 2 + 1];
                const size_t off = ((size_t)b * 4096 + n * 256 + rl) * 4096 + hh * 512 + u.pn * 256 + wc * 32 + 8 * fq;
#pragma unroll
                for (int bj = 0; bj < 2; ++bj) { const u32x4 gr = gpl[sl][bj];
                    const float gv[8] = {bf_lo(gr.x), bf_hi(gr.x), bf_lo(gr.y), bf_hi(gr.y), bf_lo(gr.z), bf_hi(gr.z), bf_lo(gr.w), bf_hi(gr.w)};
                    f32x4 y0, y1;
#pragma unroll
                    for (int j = 0; j < 4; ++j) { y0[j] = (acc[ai][bj][m][0][j] - mean) * rstd * gv[j] / (1.f + __expf(-gv[j])); y1[j] = (acc[ai][bj][m][1][j] - mean) * rstd * gv[4 + j] / (1.f + __expf(-gv[4 + j])); }
                    *(u32x4*)(Y + off + bj * HALF) = pack8(y0, y1); }
                asm volatile("" ::: "memory"); }
#undef GLOADG
        __syncthreads();
    }
};
struct EpiFoxIn {
    static constexpr bool PERM = true;
    bf16* O; const float* qg; const float* kg; PG8_LAS unsigned char* xl;
    DI void operator()(f32x4 (&acc)[2][2][4][2], const Unit& u, int wr, int wc, int fr, int fq) const {
        const int row0 = u.pm * BM + wr * 64 + fr, col0 = u.pn * BM + wc * 32 + 8 * fq;
        if (u.pn < 16) {
            const float* gn = (u.pn < 8 ? qg : kg) + wc * 32 + 8 * fq;
            const int tid = (wr * 4 + wc) * 64 + fq * 16 + fr;
            PG8_LAS float* P = (PG8_LAS float*)xl; PG8_LAS float* S = (PG8_LAS float*)(xl + 8192);
#pragma unroll
            for (int ai = 0; ai < 2; ++ai)
#pragma unroll
                for (int m = 0; m < 4; ++m) { const int rl = ai * HALF + wr * 64 + m * 16 + fr;
#pragma unroll
                    for (int bj = 0; bj < 2; ++bj) { const f32x4 a0 = acc[ai][bj][m][0], a1 = acc[ai][bj][m][1];
                        float ss = (a0[0] * a0[0] + a0[1] * a0[1]) + (a0[2] * a0[2] + a0[3] * a0[3]) + (a1[0] * a1[0] + a1[1] * a1[1]) + (a1[2] * a1[2] + a1[3] * a1[3]);
                        ss += __shfl_xor(ss, 16); ss += __shfl_xor(ss, 32);
                        if (fq == 0) P[(rl * 2 + bj) * 4 + wc] = ss; } }
            __syncthreads();
            { const float ss = (P[tid * 4] + P[tid * 4 + 1]) + (P[tid * 4 + 2] + P[tid * 4 + 3]); S[tid] = rsqrtf(ss * (1.f / 128.f) + 1e-6f); }
            __syncthreads();
            const f32x4 g0 = *(const f32x4*)(gn), g1 = *(const f32x4*)(gn + 4);
#pragma unroll
            for (int ai = 0; ai < 2; ++ai)
#pragma unroll
                for (int m = 0; m < 4; ++m) { int rl = ai * HALF + wr * 64 + m * 16 + fr; asm volatile("" : "+v"(rl)); bf16* rowp = O + (size_t)(u.pm * BM + rl) * 8192 + col0;
#pragma unroll
                    for (int bj = 0; bj < 2; ++bj) { const float r = S[rl * 2 + bj]; *(u32x4*)(rowp + bj * HALF) = pack8(acc[ai][bj][m][0] * r * g0, acc[ai][bj][m][1] * r * g1); }
                    asm volatile("" ::: "memory"); }
            __syncthreads();
        } else {
#pragma unroll
            for (int ai = 0; ai < 2; ++ai)
#pragma unroll
                for (int m = 0; m < 4; ++m) { int rr = row0 + ai * HALF + m * 16; asm volatile("" : "+v"(rr)); bf16* rowp = O + (size_t)rr * 8192 + col0;
#pragma unroll
                    for (int bj = 0; bj < 2; ++bj) *(u32x4*)(rowp + bj * HALF) = pack8(acc[ai][bj][m][0], acc[ai][bj][m][1]); }
        }
    }
};
struct EpiRetNat {
    static constexpr bool PERM = true;
    bf16* ACAT; bf16* KNAT; bf16* GATE; const float* cosT; const float* sinT; const float* gpow; bf16* KDT; const float* kdec;
    DI void operator()(const f32x4 (&acc)[2][2][4][2], const Unit& u, int wr, int wc, int fr, int fq) const {
        const int b = u.pm >> 4, n = u.pm & 15;
        if (u.pn < 16) {
            const bool isq = u.pn < 8; const int hh = u.pn & 7; const int batch = (b * 8 + hh) * 16 + n;
            const int c0 = wc * 32 + 8 * fq;
#pragma unroll
            for (int ai = 0; ai < 2; ++ai)
#pragma unroll
                for (int m = 0; m < 4; ++m) {
                    int rl = ai * HALF + wr * 64 + m * 16 + fr; asm volatile("" : "+v"(rl)); const int pos = n * 256 + rl;
                    const float sc = isq ? gpow[hh * 260 + rl + 1] : 0.0625f;
                    f32x4 y1[2], y2[2];
#pragma unroll
                    for (int n2 = 0; n2 < 2; ++n2) {
                        const f32x4 cs = *(const f32x4*)(cosT + (size_t)pos * 128 + c0 + 4 * n2), sn = *(const f32x4*)(sinT + (size_t)pos * 128 + c0 + 4 * n2);
                        const f32x4 x1 = acc[ai][0][m][n2], x2 = acc[ai][1][m][n2];
                        y1[n2] = (x1 * cs - x2 * sn) * sc; y2[n2] = (x1 * sn + x2 * cs) * sc; }
                    bf16* dst = isq ? (ACAT + ((size_t)batch * 256 + rl) * 512 + 256 + c0) : (KNAT + ((size_t)batch * 256 + rl) * 256 + c0);
                    *(u32x4*)(dst) = pack8(y1[0], y1[1]); *(u32x4*)(dst + HALF) = pack8(y2[0], y2[1]);
                    if (!isq) {
                        const float kd = kdec[hh * 256 + rl]; const bool odd = (fr & 1) != 0;
                        bf16* kt = KDT + ((size_t)batch * 256 + c0 + (odd ? HALF : 0)) * 256 + (rl & ~1);
#pragma unroll
                        for (int n2 = 0; n2 < 2; ++n2)
#pragma unroll
                            for (int j = 0; j < 4; ++j) { const float a = y1[n2][j] * kd, b = y2[n2][j] * kd;
                                const float pa = __shfl_xor(a, 1), pb = __shfl_xor(b, 1);
                                const unsigned w = odd ? cvt_pk_bf16(pb, b) : cvt_pk_bf16(a, pa);
                                *(unsigned*)(kt + (size_t)(4 * n2 + j) * 256) = w; }
                    }
                    asm volatile("" ::: "memory");
                }
        } else {
            const int row0 = u.pm * BM + wr * 64 + fr, col0 = (u.pn - 16) * BM + wc * 32 + 8 * fq;
#pragma unroll
            for (int ai = 0; ai < 2; ++ai)
#pragma unroll
                for (int m = 0; m < 4; ++m) { int rr = row0 + ai * HALF + m * 16; asm volatile("" : "+v"(rr)); bf16* rowp = GATE + (size_t)rr * 4096 + col0;
#pragma unroll
                    for (int bj = 0; bj < 2; ++bj) *(u32x4*)(rowp + bj * HALF) = pack8(acc[ai][bj][m][0], acc[ai][bj][m][1]); }
        }
    }
};
struct EpiRetSwap {
    static constexpr bool PERM = true;
    bf16* BCAT;
    DI void operator()(const f32x4 (&acc)[2][2][4][2], const Unit& u, int wr, int wc, int fr, int fq) const {
        const int b = u.pn >> 4, n = u.pn & 15;
        const int vt = u.pm, hh = vt >> 1, voff = (vt & 1) * 256, batch = (b * 8 + hh) * 16 + n;
#pragma unroll
        for (int ai = 0; ai < 2; ++ai)
#pragma unroll
            for (int m = 0; m < 4; ++m) { int v = voff + ai * HALF + wr * 64 + m * 16 + fr; asm volatile("" : "+v"(v)); bf16* rowp = BCAT + ((size_t)batch * 512 + v) * 512 + wc * 32 + 8 * fq;
#pragma unroll
                for (int bj = 0; bj < 2; ++bj) *(u32x4*)(rowp + bj * HALF) = pack8(acc[ai][bj][m][0], acc[ai][bj][m][1]); }
    }
};
struct EpiU {
    static constexpr bool PERM = true;
    bf16* U;
    DI void operator()(const f32x4 (&acc)[2][2][4][2], const Unit& u, int wr, int wc, int fr, int fq) const {
#pragma unroll
        for (int ai = 0; ai < 2; ++ai)
#pragma unroll
            for (int m = 0; m < 4; ++m) { int v = u.pn * 256 + ai * HALF + wr * 64 + m * 16 + fr; asm volatile("" : "+v"(v)); bf16* rowp = U + ((size_t)u.pm * 512 + v) * 256 + wc * 32 + 8 * fq;
#pragma unroll
                for (int bj = 0; bj < 2; ++bj) *(u32x4*)(rowp + bj * HALF) = pack8(acc[ai][bj][m][0], acc[ai][bj][m][1]); }
    }
};
struct EpiT {
    static constexpr bool PERM = true;
    bf16* ACAT; const float* ginv;
    DI void operator()(const f32x4 (&acc)[2][2][4][2], const Unit& u, int wr, int wc, int fr, int fq) const {
        const int hh = (u.pm >> 4) & 7;
#pragma unroll
        for (int ai = 0; ai < 2; ++ai)
#pragma unroll
            for (int m = 0; m < 4; ++m) { int q = ai * HALF + wr * 64 + m * 16 + fr; asm volatile("" : "+v"(q)); bf16* rowp = ACAT + ((size_t)u.pm * 256 + q) * 512 + wc * 32 + 8 * fq;
#pragma unroll
                for (int bj = 0; bj < 2; ++bj) { const int k0 = bj * HALF + wc * 32 + 8 * fq; const float dq = (float)(q - k0 + 1);
                    f32x4 t[2];
#pragma unroll
                    for (int n2 = 0; n2 < 2; ++n2) { const f32x4 gi = *(const f32x4*)(ginv + hh * 256 + k0 + 4 * n2); t[n2] = acc[ai][bj][m][n2] * gi;
#pragma unroll
                        for (int j = 0; j < 4; ++j) t[n2][j] *= __builtin_amdgcn_fmed3f(dq - (float)(4 * n2 + j), 0.f, 1.f); }
                    *(u32x4*)(rowp + bj * HALF) = pack8(t[0], t[1]); }
                asm volatile("" ::: "memory"); }
    }
};
struct EpiO {
    static constexpr bool PERM = true;
    bf16* O;
    DI void operator()(const f32x4 (&acc)[2][2][4][2], const Unit& u, int wr, int wc, int fr, int fq) const {
        const int batch = u.pm, b = batch >> 7, hh = (batch >> 4) & 7, n = batch & 15;
#pragma unroll
        for (int ai = 0; ai < 2; ++ai)
#pragma unroll
            for (int m = 0; m < 4; ++m) { int rl = ai * HALF + wr * 64 + m * 16 + fr; asm volatile("" : "+v"(rl)); bf16* rowp = O + ((size_t)b * 4096 + n * 256 + rl) * 4096 + hh * 512 + u.pn * 256 + wc * 32 + 8 * fq;
#pragma unroll
                for (int bj = 0; bj < 2; ++bj) *(u32x4*)(rowp + bj * HALF) = pack8(acc[ai][bj][m][0], acc[ai][bj][m][1]); }
    }
};

#ifndef SP2_DEFAULT
#define SP2_DEFAULT true
#endif
template <class Epi, bool ALIGN_EPI = true, bool SP2 = SP2_DEFAULT>
DI void gemm_phase(PG8_LAS unsigned char* lds, const Gemm g, const Sched& S, const Epi& E, const int tid) {
    const int wid = __builtin_amdgcn_readfirstlane(tid >> 6), lane = tid & 63, wr = wid >> 2, wc = wid & 3, fr = lane & 15, fq = lane >> 4;
    const int K = g.K, nt = K / BK;
    unsigned vooffA, vooffB;
    { int R, C; stage_rc(tid * 16, R, C); const int Rb = Epi::PERM ? ((R & ~31) + perm32(R & 31)) : R;
      vooffA = (unsigned)(R * g.lda + C) * 2u; vooffB = (unsigned)(Rb * g.ldb + C) * 2u; }
    const size_t r64offA = (size_t)64 * g.lda * 2, r64offB = (size_t)64 * g.ldb * 2;
    const size_t kstep = (size_t)(BK * 2);
    const size_t hstepA = (size_t)HALF * g.lda * 2, hstepB = (size_t)HALF * g.ldb * 2;
    const unsigned ldsw = (unsigned)wid * 1024u;
    const int aoff = lds_byte(wr * 64 + fr, fq * 8), boff = lds_byte(wc * 32 + fr, fq * 8);
#define PG8_SA(b, h) (((b) * 2 + (h)) * HTB)
#define PG8_SB(b, h) ((4 + (b) * 2 + (h)) * HTB)
#define PG8_STAGE(bufoff, gbase, voff) do { _Pragma("unroll") for (int _i = 0; _i < 2; ++_i) \
        __builtin_amdgcn_global_load_lds((const unsigned*)((const char*)(gbase) + (size_t)_i * r64##voff + (vo##voff)), (PG8_LAS unsigned*)(lds + (bufoff) + ldsw + _i * 8192), 16, 0, 0); } while (0)
#define PG8_LDA(dst, b, h) do { _Pragma("unroll") for (int m = 0; m < 4; ++m) _Pragma("unroll") for (int k = 0; k < 2; ++k) dst[m][k] = *(const PG8_LAS bf16x8*)(lds + PG8_SA(b, h) + aoff + m * 2048 + k * 1024); } while (0)
#define PG8_LDB(dst, b, h) do { _Pragma("unroll") for (int n = 0; n < 2; ++n) _Pragma("unroll") for (int k = 0; k < 2; ++k) dst[n][k] = *(const PG8_LAS bf16x8*)(lds + PG8_SB(b, h) + boff + n * 2048 + k * 1024); } while (0)
#define PG8_MMA(ai, bj, At, Bt) do { __builtin_amdgcn_s_setprio(1); _Pragma("unroll") for (int m = 0; m < 4; ++m) _Pragma("unroll") for (int n = 0; n < 2; ++n) _Pragma("unroll") for (int k = 0; k < 2; ++k) \
        acc[ai][bj][m][n] = __builtin_amdgcn_mfma_f32_16x16x32_bf16(Bt[n][k], At[m][k], acc[ai][bj][m][n], 0, 0, 0); __builtin_amdgcn_s_setprio(0); } while (0)
#define PG8_WAIT_V(n) asm volatile("s_waitcnt vmcnt(" #n ")" ::: "memory")
#define PG8_WAIT_L(n) asm volatile("s_waitcnt lgkmcnt(" #n ")" ::: "memory")
#define PG8_BAR __builtin_amdgcn_s_barrier()
#define PG8_SCHED __builtin_amdgcn_sched_barrier(0)
    Unit cur, nxt; int ui = 0;
    if (!S.next(0, cur)) return;
    f32x4 acc[2][2][4][2];
#pragma unroll
    for (int a = 0; a < 2; ++a)
#pragma unroll
        for (int b = 0; b < 2; ++b)
#pragma unroll
            for (int m = 0; m < 4; ++m)
#pragma unroll
                for (int n = 0; n < 2; ++n) acc[a][b][m][n] = (f32x4){0.f, 0.f, 0.f, 0.f};
    bf16x8 At[4][2], B0[2][2], B1[2][2];
    const char* cA = (const char*)g.A + cur.aoff; const char* cB = (const char*)g.Bt + cur.boff;
    if constexpr (SP2) {
        PG8_STAGE(PG8_SB(0, 0), cB, offB); PG8_STAGE(PG8_SB(0, 1), cB + hstepB, offB); PG8_STAGE(PG8_SA(0, 0), cA, offA); PG8_STAGE(PG8_SA(0, 1), cA + hstepA, offA);
        if (wr == 1) PG8_BAR;
        PG8_WAIT_V(2); PG8_BAR;
        PG8_STAGE(PG8_SB(1, 0), cB + kstep, offB); PG8_STAGE(PG8_SA(1, 0), cA + kstep, offA); PG8_STAGE(PG8_SB(1, 1), cB + hstepB + kstep, offB);
        PG8_WAIT_V(6); PG8_BAR;
    } else {
        PG8_STAGE(PG8_SB(0, 0), cB, offB); PG8_STAGE(PG8_SA(0, 0), cA, offA); PG8_STAGE(PG8_SB(0, 1), cB + hstepB, offB); PG8_STAGE(PG8_SA(0, 1), cA + hstepA, offA);
        if (wr == 1) PG8_BAR;
        PG8_WAIT_V(4); PG8_BAR;
        PG8_STAGE(PG8_SB(1, 0), cB + kstep, offB); PG8_STAGE(PG8_SA(1, 0), cA + kstep, offA); PG8_STAGE(PG8_SB(1, 1), cB + hstepB + kstep, offB);
        PG8_WAIT_V(6); PG8_BAR;
    }
    for (;;) {
        const bool has_next = S.next(ui + 1, nxt);
        const char* nA = has_next ? (const char*)g.A + nxt.aoff : cA; const char* nB = has_next ? (const char*)g.Bt + nxt.boff : cB;
#pragma unroll 1
        for (int t = 0; t < nt; t += 2) {
            const bool last = (t == nt - 2);
            const char* a1 = cA + (size_t)(t + 1) * kstep;
            const char* a2 = last ? nA : cA + (size_t)(t + 2) * kstep; const char* b2 = last ? nB : cB + (size_t)(t + 2) * kstep;
            const char* a3 = a2 + kstep; const char* b3 = b2 + kstep;
            if constexpr (SP2) {
            PG8_LDB(B0, 0, 0); PG8_LDB(B1, 0, 1); PG8_SCHED; PG8_LDA(At, 0, 0); PG8_STAGE(PG8_SA(1, 1), a1 + hstepA, offA);
            PG8_WAIT_V(8); PG8_WAIT_L(0); PG8_BAR; PG8_MMA(0, 0, At, B0); PG8_MMA(0, 1, At, B1); PG8_BAR; PG8_SCHED;
            PG8_LDA(At, 0, 1); PG8_STAGE(PG8_SB(0, 0), b2, offB); PG8_STAGE(PG8_SB(0, 1), b2 + hstepB, offB); PG8_STAGE(PG8_SA(0, 0), a2, offA);
            PG8_WAIT_V(8); PG8_WAIT_L(0); PG8_BAR; PG8_MMA(1, 0, At, B0); PG8_MMA(1, 1, At, B1); PG8_BAR; PG8_SCHED;
            PG8_LDB(B0, 1, 0); PG8_LDB(B1, 1, 1); PG8_SCHED; PG8_LDA(At, 1, 0); PG8_STAGE(PG8_SA(0, 1), a2 + hstepA, offA);
            PG8_WAIT_V(8); PG8_WAIT_L(0); PG8_BAR; PG8_MMA(0, 0, At, B0); PG8_MMA(0, 1, At, B1); PG8_BAR; PG8_SCHED;
            PG8_LDA(At, 1, 1); PG8_STAGE(PG8_SB(1, 0), b3, offB); PG8_STAGE(PG8_SB(1, 1), b3 + hstepB, offB); PG8_STAGE(PG8_SA(1, 0), a3, offA);
            PG8_WAIT_V(8); PG8_WAIT_L(0); PG8_BAR; PG8_MMA(1, 0, At, B0); PG8_MMA(1, 1, At, B1); PG8_BAR; PG8_SCHED;
            } else {
            PG8_LDB(B0, 0, 0); PG8_SCHED; PG8_LDA(At, 0, 0); PG8_STAGE(PG8_SA(1, 1), a1 + hstepA, offA);
            PG8_WAIT_L(8); PG8_BAR; PG8_WAIT_L(0); PG8_MMA(0, 0, At, B0); PG8_BAR; PG8_SCHED;
            PG8_LDB(B1, 0, 1); PG8_STAGE(PG8_SB(0, 0), b2, offB);
            PG8_BAR; PG8_WAIT_L(0); PG8_MMA(0, 1, At, B1); PG8_BAR;
            PG8_LDA(At, 0, 1); PG8_STAGE(PG8_SA(0, 0), a2, offA);
            PG8_BAR; PG8_WAIT_L(0); PG8_MMA(1, 0, At, B0); PG8_BAR; PG8_SCHED;
            PG8_STAGE(PG8_SB(0, 1), b2 + hstepB, offB);
            PG8_WAIT_V(6); PG8_BAR; PG8_MMA(1, 1, At, B1); PG8_BAR;
            PG8_LDB(B0, 1, 0); PG8_SCHED; PG8_LDA(At, 1, 0); PG8_STAGE(PG8_SA(0, 1), a2 + hstepA, offA);
            PG8_WAIT_L(8); PG8_BAR; PG8_WAIT_L(0); PG8_MMA(0, 0, At, B0); PG8_BAR; PG8_SCHED;
            PG8_LDB(B1, 1, 1); PG8_STAGE(PG8_SB(1, 0), b3, offB);
            PG8_BAR; PG8_WAIT_L(0); PG8_MMA(0, 1, At, B1); PG8_BAR;
            PG8_LDA(At, 1, 1); PG8_STAGE(PG8_SA(1, 0), a3, offA);
            PG8_BAR; PG8_WAIT_L(0); PG8_MMA(1, 0, At, B0); PG8_BAR; PG8_SCHED;
            PG8_STAGE(PG8_SB(1, 1), b3 + hstepB, offB);
            PG8_WAIT_V(6); PG8_BAR; PG8_MMA(1, 1, At, B1); PG8_BAR;
            }
        }
        if constexpr (ALIGN_EPI) { if (wr == 0) PG8_BAR; }
        { int te = tid; asm volatile("" : "+v"(te)); const int le = te & 63; E(acc, cur, wr, wc, le & 15, le >> 4); }
        if (!has_next) break;
#pragma unroll
        for (int a = 0; a < 2; ++a)
#pragma unroll
            for (int b = 0; b < 2; ++b)
#pragma unroll
                for (int m = 0; m < 4; ++m)
#pragma unroll
                    for (int n = 0; n < 2; ++n) acc[a][b][m][n] = (f32x4){0.f, 0.f, 0.f, 0.f};
        cur = nxt; cA = nA; cB = nB; ++ui;
        if constexpr (ALIGN_EPI) { if (wr == 1) PG8_BAR; }
    }
    PG8_WAIT_V(0);
    if constexpr (!ALIGN_EPI) { if (wr == 0) PG8_BAR; }
    PG8_BAR;
#undef PG8_SA
#undef PG8_SB
#undef PG8_STAGE
#undef PG8_LDA
#undef PG8_LDB
#undef PG8_MMA
#undef PG8_WAIT_V
#undef PG8_WAIT_L
#undef PG8_BAR
#undef PG8_SCHED
}
}

namespace fa {
constexpr int D = 128, NW = 8, QBLK = 32, KVBLK = 64, QB = NW * QBLK;
constexpr int SHM_V = KVBLK * D * 2, SHM_K = KVBLK * D * 2, SHM_A = KVBLK * 4;
constexpr int NRING = 3;
constexpr int LDS_WS = NRING * SHM_V + NRING * SHM_K, LDS_BIAS = LDS_WS + NW * 64 * 4, LDS_SCAN = LDS_BIAS + 4096 * 4, LDS_BYTES = LDS_SCAN + 64;
constexpr float SCALE = 0.08838834764831845f, THR = 8.f;
constexpr int KP = 8192, OP = 2048;
#define KSWZ(row, colB) ((row) * 256 + ((colB) ^ (((row) & 7) << 4)))
#define SBAR() __builtin_amdgcn_sched_barrier(0)
DI int v_st(int k, int c) { const int kk = (k & ~0xC) | ((k & 4) << 1) | ((k & 8) >> 1); return ((kk >> 3) * 4 + (c >> 5)) * 512 + ((kk & 7) * 32 + (c & 31)) * 2; }
DI int v_rd_base(int lane) { return ((lane & 3) << 3) | (((lane >> 2) & 3) << 6) | (((lane >> 4) & 1) << 5) | (((lane >> 5) & 1) << 8); }
constexpr int v_rd_off(int d0, int ks, int half) { return d0 * 512 + ks * 4096 + half * 2048; }
DI int crow(int r, int hi) { return (r & 3) + 8 * (r >> 2) + 4 * hi; }
DI unsigned cvtpk(float lo, float hi) { unsigned r; asm volatile("v_cvt_pk_bf16_f32 %0, %1, %2" : "=v"(r) : "v"(lo), "v"(hi)); return r; }
DI bf16x8 load8(const bf16* p) { return *reinterpret_cast<const bf16x8*>(p); }
DI void mask_tile(f32x16& p0, f32x16& p1, int dq) {
    const float NEG = -__builtin_inff();
#pragma unroll
    for (int r = 0; r < 16; ++r) {
        const int c = (r & 3) + 8 * (r >> 2);
        if (dq - c < 0) p0[r] = NEG;
        if (dq - c - 32 < 0) p1[r] = NEG;
    }
}
DI void partialSM(f32x16& p0, f32x16& p1, float& m_reg, float& mn, float& alpha) {
    float pmax = p0[0]; for (int r = 1; r < 16; ++r) pmax = fmaxf(pmax, p0[r]); for (int r = 0; r < 16; ++r) pmax = fmaxf(pmax, p1[r]);
    { auto rr = __builtin_amdgcn_permlane32_swap(__float_as_uint(pmax), __float_as_uint(pmax), false, false);
      pmax = fmaxf(__uint_as_float(rr[0]), __uint_as_float(rr[1])); }
    constexpr float C2 = 1.4426950408889634f * SCALE;
    if (__builtin_expect(__all((pmax - m_reg) * SCALE <= THR), 1)) { mn = m_reg; alpha = 1.f; }
    else { mn = fmaxf(m_reg, pmax); alpha = __builtin_amdgcn_exp2f((m_reg - mn) * C2); m_reg = mn; }
    const float mnL = -mn * C2;
    for (int r = 0; r < 16; ++r) p0[r] = fmaf(p0[r], C2, mnL); for (int r = 0; r < 16; ++r) p1[r] = fmaf(p1[r], C2, mnL);
    for (int r = 0; r < 16; ++r) p0[r] = __builtin_amdgcn_exp2f(p0[r]);
}
DI void finishSM(f32x16& p0, f32x16& p1, float alpha, float& l_reg, bf16x8& pa0, bf16x8& pa1, bf16x8& pa2, bf16x8& pa3) {
    for (int r = 0; r < 16; ++r) p1[r] = __builtin_amdgcn_exp2f(p1[r]);
    float ps = 0; for (int r = 0; r < 16; ++r) ps += p0[r]; for (int r = 0; r < 16; ++r) ps += p1[r];
    { auto rr = __builtin_amdgcn_permlane32_swap(__float_as_uint(ps), __float_as_uint(ps), false, false);
      ps = __uint_as_float(rr[0]) + __uint_as_float(rr[1]); }
    l_reg = l_reg * alpha + ps;
#define PK4(P, B_, OUT) do { unsigned a0 = cvtpk(P[B_+0], P[B_+1]), a1 = cvtpk(P[B_+2], P[B_+3]);                          \
        unsigned b0 = cvtpk(P[B_+4], P[B_+5]), b1 = cvtpk(P[B_+6], P[B_+7]);                                             \
        auto r0 = __builtin_amdgcn_permlane32_swap(a0, b0, false, false); auto r1 = __builtin_amdgcn_permlane32_swap(a1, b1, false, false); \
        u32x4 w = {r0[0], r1[0], r0[1], r1[1]}; OUT = *reinterpret_cast<bf16x8*>(&w); } while (0)
    PK4(p0, 0, pa0); PK4(p0, 8, pa1); PK4(p1, 0, pa2); PK4(p1, 8, pa3);
#undef PK4
}
DI void qkt(f32x16& p0, f32x16& p1, const char* K_lds, const int kslot, const char* bias_t, int r32, int hi, const bf16x8* qr) {
    {
        const char* ab = bias_t + hi * 16;
#pragma unroll
        for (int g = 0; g < 4; ++g) { const f32x4 b0 = *reinterpret_cast<const f32x4*>(ab + g * 32), b1 = *reinterpret_cast<const f32x4*>(ab + 128 + g * 32);
            p0[4 * g] = b0[0]; p0[4 * g + 1] = b0[1]; p0[4 * g + 2] = b0[2]; p0[4 * g + 3] = b0[3];
            p1[4 * g] = b1[0]; p1[4 * g + 1] = b1[1]; p1[4 * g + 2] = b1[2]; p1[4 * g + 3] = b1[3]; }
    }
    const char* kb[4];
#pragma unroll
    for (int dd = 0; dd < 4; ++dd) kb[dd] = K_lds + kslot * SHM_K + KSWZ(r32, (dd * 16 + hi * 8) * 2);
#pragma unroll
    for (int d0 = 0; d0 < 8; ++d0) { const char* a = kb[d0 & 3] + (d0 >> 2) * 128;
        bf16x8 b0 = *reinterpret_cast<const bf16x8*>(a);
        bf16x8 b1 = *reinterpret_cast<const bf16x8*>(a + 32 * 256);
        p0 = __builtin_amdgcn_mfma_f32_32x32x16_bf16(b0, qr[d0], p0, 0, 0, 0);
        p1 = __builtin_amdgcn_mfma_f32_32x32x16_bf16(b1, qr[d0], p1, 0, 0, 0); }
}
DI void pv_tile(f32x16* o, const int vb0, bf16x8 pa0, bf16x8 pa1, bf16x8 pa2, bf16x8 pa3) {
#define TRRD(dst, off) asm volatile("ds_read_b64_tr_b16 %0, %1 offset:%2" : "=&v"(dst) : "v"(vb0), "i"(off) : "memory")
#define PV_D0(d0) do { s16x4 l0, l1, l2, l3, h0, h1, h2, h3; constexpr int b_ = v_rd_off(d0, 0, 0); \
        TRRD(l0, b_); TRRD(h0, b_ + 2048); TRRD(l1, b_ + 4096); TRRD(h1, b_ + 6144); TRRD(l2, b_ + 8192); TRRD(h2, b_ + 10240); TRRD(l3, b_ + 12288); TRRD(h3, b_ + 14336); \
        asm volatile("s_waitcnt lgkmcnt(0)" ::: "memory"); SBAR();   \
        o[d0] = __builtin_amdgcn_mfma_f32_32x32x16_bf16(pa0, (bf16x8){l0[0], l0[1], l0[2], l0[3], h0[0], h0[1], h0[2], h0[3]}, o[d0], 0, 0, 0);   \
        o[d0] = __builtin_amdgcn_mfma_f32_32x32x16_bf16(pa1, (bf16x8){l1[0], l1[1], l1[2], l1[3], h1[0], h1[1], h1[2], h1[3]}, o[d0], 0, 0, 0);   \
        o[d0] = __builtin_amdgcn_mfma_f32_32x32x16_bf16(pa2, (bf16x8){l2[0], l2[1], l2[2], l2[3], h2[0], h2[1], h2[2], h2[3]}, o[d0], 0, 0, 0);   \
        o[d0] = __builtin_amdgcn_mfma_f32_32x32x16_bf16(pa3, (bf16x8){l3[0], l3[1], l3[2], l3[3], h3[0], h3[1], h3[2], h3[3]}, o[d0], 0, 0, 0); } while (0)
    PV_D0(0); PV_D0(1); PV_D0(2); PV_D0(3);
#undef PV_D0
#undef TRRD
}
struct BlockRef { const bf16* Q; const bf16* KV; bf16* O; int P0; };
struct Seam { bf16x8 qr[8]; bf16x8 st_v0, st_v1, st_k0, st_k1; };
#define ROW(p, k0, rr) (((p) + (size_t)((k0) + (rr)) * KP) + toff)
#define VMW() asm volatile("s_waitcnt vmcnt(0)" ::: "memory")
#define VMWN(n) asm volatile("s_waitcnt vmcnt(%0)" :: "i"(n) : "memory")
#define SLOAD_H(Kp, Vp, Ap, k0, bf) do { S.st_v0 = load8(ROW(Vp, k0, 0)); S.st_v1 = load8(ROW(Vp, k0, 32));              \
                         S.st_k0 = load8(ROW(Kp, k0, 0)); S.st_k1 = load8(ROW(Kp, k0, 32)); \
                         } while (0)
#define SWRITE_HK(bf) do { *(bf16x8*)(K_lds + (bf) * SHM_K + kws) = S.st_k0; *(bf16x8*)(K_lds + (bf) * SHM_K + kws + 32 * 256) = S.st_k1; } while (0)
#define SWRITE_HV(bf) do { *(bf16x8*)(V_lds + (bf) * SHM_V + vst0) = S.st_v0; *(bf16x8*)(V_lds + (bf) * SHM_V + vst1) = S.st_v1; } while (0)
#define SWRITE_H(bf) do { SWRITE_HV(bf); SWRITE_HK(bf); } while (0)
DI void prime(const BlockRef& cur, char* lds, Seam& S, const int tid) {
    const int wid = __builtin_amdgcn_readfirstlane(tid >> 6), lane = tid & 63, r32 = lane & 31, hi = lane >> 5;
    const int sr = tid >> 4, sc = (tid & 15) * 8, kws = KSWZ(sr, sc * 2); const unsigned toff = (unsigned)(sr * KP + sc); char* K_lds = lds + NRING * SHM_V;
    for (int d0 = 0; d0 < 8; ++d0) S.qr[d0] = load8(cur.Q + (size_t)(wid * QBLK + r32) * KP + d0 * 16 + hi * 8);
    SLOAD_H(cur.KV + 2048, cur.KV + 4096, 0, 0, 0); VMW(); SWRITE_HK(0);
    __syncthreads();
}
DI void block(const BlockRef& cur, const BlockRef& nxt, char* lds, Seam& S, const int tid) {
    const int wid = __builtin_amdgcn_readfirstlane(tid >> 6), lane = tid & 63, r32 = lane & 31, hi = lane >> 5;
    const int NT = (cur.P0 + QB - 1) / KVBLK + 1;
    const int qlo = cur.P0 + wid * QBLK, qm = qlo + r32 - 4 * hi;
    char* V_lds = lds; char* K_lds = lds + NRING * SHM_V; const char* B_lds = lds + LDS_BIAS;
    float* ws = (float*)(lds + LDS_WS) + wid * 64; float* li_l = ws, * al_l = ws + 32;
    float m_reg = -1e30f, l_reg = 0; f32x16 o[4] = {};
    const int sr = tid >> 4, sc = (tid & 15) * 8, vst0 = v_st(sr, sc), vst1 = v_st(32 + sr, sc), kws = KSWZ(sr, sc * 2); const unsigned toff = (unsigned)(sr * KP + sc);
    const int vb0 = (int)(uintptr_t)V_lds + v_rd_base(lane);
    const bf16* Kh = cur.KV + 2048; const bf16* Vh = cur.KV + 4096;
#define RESC(a) do { if (__any((a) < 1.f)) { if (hi == 0) al_l[r32] = (a); asm volatile("s_waitcnt lgkmcnt(0)" ::: "memory");              \
                     for (int d_ = 0; d_ < 4; ++d_) for (int r = 0; r < 16; ++r) o[d_][r] *= al_l[crow(r, hi)]; } } while (0)
#define KBASE(t) ((t) * KVBLK)
#define MASKT(P0_, P1_, t) do { const int kb_ = KBASE(t); if (kb_ + KVBLK - 1 > qlo) mask_tile(P0_, P1_, qm - kb_); } while (0)
    constexpr int NQL = 8;
#define SEAM_K0() do { VMWN(NQL); SWRITE_HK(0); SBAR(); } while (0)
    f32x16 pA0, pA1, pB0, pB1; float mnA, mnB, alA, alB; bf16x8 pa0, pa1, pa2, pa3;
    SWRITE_HV(0); SBAR();
    if (NT > 1) { SLOAD_H(Kh, Vh, 0, KBASE(1), 1); }
    SBAR(); qkt(pA0, pA1, K_lds, 0, B_lds, r32, hi, S.qr);
    MASKT(pA0, pA1, 0); partialSM(pA0, pA1, m_reg, mnA, alA);
    if (NT > 1) { VMW(); SWRITE_H(1); }
    __syncthreads();
#define HALF_STEP(PX0, PX1, mnX, alX, PY0, PY1, alY, t) do {                                                      \
        SBAR(); qkt(PX0, PX1, K_lds, rt, B_lds + KBASE(t) * 4, r32, hi, S.qr);                                             \
        finishSM(PY0, PY1, alY, l_reg, pa0, pa1, pa2, pa3); SBAR();                                                           \
        if ((t) + 1 < NT) { SLOAD_H(Kh, Vh, 0, KBASE((t) + 1), 0); SBAR(); }                                               \
        pv_tile(o, vb0 + rp * SHM_V, pa0, pa1, pa2, pa3); MASKT(PX0, PX1, (t)); partialSM(PX0, PX1, m_reg, mnX, alX);                                        \
        if ((t) + 1 < NT) { VMW(); SWRITE_H(rn); }                                                                          \
        RESC(alX); __syncthreads();                                                                                          \
        rp = rt; rt = rn; rn = (rn == NRING - 1) ? 0 : rn + 1; } while (0)
    int rp = 0, rt = 1, rn = 2;
    for (int t = 1; t + 1 < NT; t += 2) {
        HALF_STEP(pB0, pB1, mnB, alB, pA0, pA1, alA, t);
        HALF_STEP(pA0, pA1, mnA, alA, pB0, pB1, alB, t + 1);
    }
    const bool even = (NT & 1) == 0;
    if (even) { SBAR(); qkt(pB0, pB1, K_lds, rt, B_lds + KBASE(NT - 1) * 4, r32, hi, S.qr); SBAR(); }
    SLOAD_H(nxt.KV + 2048, nxt.KV + 4096, 0, 0, 0); SBAR();
#pragma unroll
    for (int d0 = 0; d0 < 8; ++d0) S.qr[d0] = load8(nxt.Q + (size_t)(wid * QBLK + r32) * KP + d0 * 16 + hi * 8);
    SBAR();
    finishSM(pA0, pA1, alA, l_reg, pa0, pa1, pa2, pa3); SBAR();
    pv_tile(o, vb0 + rp * SHM_V, pa0, pa1, pa2, pa3);
    if (even) { MASKT(pB0, pB1, NT - 1); partialSM(pB0, pB1, m_reg, mnB, alB); __syncthreads(); RESC(alB);
        finishSM(pB0, pB1, alB, l_reg, pa0, pa1, pa2, pa3); SBAR(); pv_tile(o, vb0 + rt * SHM_V, pa0, pa1, pa2, pa3); }
    SBAR(); SEAM_K0();
    if (hi == 0) li_l[r32] = l_reg; asm volatile("s_waitcnt lgkmcnt(0)" ::: "memory");
    float rli[16];
#pragma unroll
    for (int r = 0; r < 16; ++r) rli[r] = __builtin_amdgcn_rcpf(li_l[crow(r, hi)]);
    { int te = tid; asm volatile("" : "+v"(te)); const int r32e = te & 31, hie = (te >> 5) & 1;
    bf16* Ow = cur.O + (size_t)(wid * QBLK) * OP + r32e; const bf16* Gw = cur.Q + 6144 + (size_t)(wid * QBLK) * KP + r32e;
    bf16 graw[2][16];
#define GLOAD(g_, sl_) do { int orow_ = 8 * (g_) + 4 * hie; asm volatile("" : "+v"(orow_)); const bf16* gp_ = Gw + (size_t)orow_ * KP; \
        _Pragma("unroll") for (int i_ = 0; i_ < 4; ++i_) _Pragma("unroll") for (int d_ = 0; d_ < 4; ++d_) graw[sl_][i_ * 4 + d_] = gp_[(size_t)i_ * KP + d_ * 32]; } while (0)
    GLOAD(0, 0);
#pragma unroll
    for (int g = 0; g < 4; ++g) {
        if (g < 3) GLOAD(g + 1, (g + 1) & 1);
        int orow = 8 * g + 4 * hie; asm volatile("" : "+v"(orow)); bf16* op = Ow + (size_t)orow * OP;
#pragma unroll
        for (int i = 0; i < 4; ++i) { const int r = 4 * g + i;
#pragma unroll
            for (int d0 = 0; d0 < 4; ++d0) { const float gt = bf2f(graw[g & 1][i * 4 + d0]);
                const float v = o[d0][r] * rli[r] * gt / (1.f + __expf(-gt));
                const float vn = __shfl_xor(v, 1);
                if ((r32e & 1) == 0) *(unsigned*)(op + (size_t)i * OP + d0 * 32) = cvtpk(v, vn); } }
        asm volatile("" ::: "memory"); } }
#undef GLOAD
    __syncthreads();
#undef RESC
#undef KBASE
#undef MASKT
#undef SEAM_K0
#undef HALF_STEP
}
#undef ROW
#undef VMW
#undef VMWN
#undef SLOAD_H
#undef SWRITE_HK
#undef SWRITE_HV
#undef SWRITE_H
DI BlockRef mkref(int bh, int qb, const bf16* PROJ, const float* AUG, bf16* Y) {
    const int b = bh >> 4, h = bh & 15; BlockRef r;
    const size_t tok0 = (size_t)b * 4096;
    r.Q = PROJ + (tok0 + (size_t)qb * QB) * KP + h * 128;
    r.KV = PROJ + tok0 * KP + h * 128;
    r.O = Y + (tok0 + (size_t)qb * QB) * OP + h * 128; r.P0 = qb * QB;
    return r;
}
DI void attn_phase(char* lds, const bf16* PROJ, const float* AUG, bf16* Y, int G, int c, const int tid) {
    constexpr int total = 256;
    int L = c; if (L >= total) return;
#define ITEM_BH(L_) ((((L_) & 7) << 2) + ((L_) >> 6))
#define ITEM_X(L_) (((L_) >> 3) & 7)
    int bh = ITEM_BH(L), x = ITEM_X(L), pass = 0;
    BlockRef cur = mkref(bh, x, PROJ, AUG, Y);
    Seam S;
#define HEAD_BIAS(bh_) do { int tl_ = tid; asm volatile("" : "+v"(tl_));     \
        const int lane_ = tl_ & 63, wave_ = __builtin_amdgcn_readfirstlane(tl_ >> 6); const float* ls_ = AUG + (size_t)(bh_) * 4096 + tl_ * 8; \
        const f32x4 a0_ = *(const f32x4*)ls_, a1_ = *(const f32x4*)(ls_ + 4); float v_[8]; float run_ = 0.f; \
        _Pragma("unroll") for (int e_ = 0; e_ < 4; ++e_) { run_ += a0_[e_]; v_[e_] = run_; } \
        _Pragma("unroll") for (int e_ = 0; e_ < 4; ++e_) { run_ += a1_[e_]; v_[4 + e_] = run_; } \
        float incl_ = run_; \
        _Pragma("unroll") for (int o_ = 1; o_ < 64; o_ <<= 1) { const float t_ = __int_as_float(__builtin_amdgcn_ds_bpermute(((lane_ - o_) & 63) << 2, __float_as_int(incl_))); if (lane_ >= o_) incl_ += t_; } \
        float* wt_ = (float*)(lds + LDS_SCAN); \
        if (lane_ == 63) wt_[wave_] = incl_; \
        __syncthreads(); \
        float base_ = incl_ - run_; for (int w_ = 0; w_ < wave_; ++w_) base_ += wt_[w_]; \
        f32x4 o0_, o1_; \
        _Pragma("unroll") for (int e_ = 0; e_ < 4; ++e_) { o0_[e_] = -(base_ + v_[e_]) * 11.313708498984761f; o1_[e_] = -(base_ + v_[4 + e_]) * 11.313708498984761f; } \
        *(f32x4*)(lds + LDS_BIAS + tl_ * 32) = o0_; *(f32x4*)(lds + LDS_BIAS + tl_ * 32 + 16) = o1_; \
        __syncthreads(); } while (0)
    HEAD_BIAS(bh);
    prime(cur, lds, S, tid);
    for (;;) {
        const bool more_pass = pass == 0, more_item = L + G < total, last = !more_pass && !more_item;
        int bhn = bh, xn = x, passn = pass + 1, Ln = L;
        if (!more_pass) { passn = 0; Ln = more_item ? L + G : L; bhn = ITEM_BH(Ln); xn = ITEM_X(Ln); }
        const BlockRef nxt = last ? cur : mkref(bhn, passn ? 15 - xn : xn, PROJ, AUG, Y);
        block(cur, nxt, lds, S, tid);
        if (last) break;
        if (bhn != bh) HEAD_BIAS(bhn);
        cur = nxt; bh = bhn; x = xn; pass = passn; L = Ln;
    }
}
}

constexpr int NTOK = 8192, DM = 2048;
constexpr size_t MiB = 1u << 20;
constexpr size_t WS_COS = 0, WS_SIN = 2 * MiB, WS_COSTT = 4 * MiB, WS_SINTT = 6 * MiB, WS_GPOW = 8 * MiB, WS_KDEC = 8 * MiB + 16384, WS_GINV = 8 * MiB + 32768;
constexpr size_t WS_BAR = 15 * MiB, WS_LNCNT = 15 * MiB + 16384, WS_GNCNT = 15 * MiB + 65536, WS_XSLOT = 13 * MiB, WS_GSLOT = 11 * MiB;
constexpr size_t WS_LOGIT = 9 * MiB, WS_AUG = 10 * MiB, WS_WFT = 12 * MiB;
constexpr size_t WS_WFI = 16 * MiB, WS_WFO = 80 * MiB, WS_WRI = 96 * MiB, WS_WRO = 192 * MiB;
constexpr size_t WS_HB = 224 * MiB, WS_H32 = 256 * MiB, WS_RA = 320 * MiB, WS_RB = 384 * MiB, WS_RK = 512 * MiB, WS_RKT = 544 * MiB, WS_RG = 576 * MiB, WS_RU = 640 * MiB, WS_END = 704 * MiB;
constexpr int LDS_BYTES = 131072 + 2048 + 10240;
#define LAS __attribute__((address_space(3)))

struct TrItem { const float* W; bf16* WT; int ldw, ldt, k0, n0; };
DI void tr_load(const TrItem& t, int lane, float (&tv)[32]) {
#pragma unroll
    for (int i = 0; i < 32; ++i) { const int kk = 2 * i + (lane >> 5); tv[i] = t.W[(size_t)(t.k0 + kk) * t.ldw + t.n0 + (lane & 31)]; }
}
DI void tr_store(const TrItem& t, int lane, const float (&tv)[32], LAS float* scr) {
#pragma unroll
    for (int i = 0; i < 32; ++i) { const int kk = 2 * i + (lane >> 5); scr[kk * 33 + (lane & 31)] = tv[i]; }
    asm volatile("s_waitcnt lgkmcnt(0)" ::: "memory");
    const int c = lane & 7;
#pragma unroll
    for (int j = 0; j < 4; ++j) { const int n = (lane >> 3) + 8 * j; const LAS float* s = scr + (8 * c) * 33 + n;
        u32x4 o; o.x = cvt_pk_bf16(s[0 * 33], s[1 * 33]); o.y = cvt_pk_bf16(s[2 * 33], s[3 * 33]); o.z = cvt_pk_bf16(s[4 * 33], s[5 * 33]); o.w = cvt_pk_bf16(s[6 * 33], s[7 * 33]);
        *(u32x4*)(t.WT + (size_t)(t.n0 + n) * t.ldt + t.k0 + 8 * c) = o; }
    asm volatile("s_waitcnt lgkmcnt(0)" ::: "memory");
}


#define XB_TMO      128
#define XB_XCNT(j)  (256  + 64 * (j))
#define XB_XSUB(j)  (1280 + 64 * (j))
#define XB_XGEN(j)  (2304 + 64 * (j))
#define XB_TOP      3328
#define XB_TOPGEN   3392
#define XCD_BAR_WORDS 3456
#define XB_SPIN_CAP (1u << 20)
DI unsigned xb_ld(unsigned* p)              { return __hip_atomic_load(p, __ATOMIC_RELAXED, __HIP_MEMORY_SCOPE_AGENT); }
DI unsigned xb_add(unsigned* p, unsigned v) { return __hip_atomic_fetch_add(p, v, __ATOMIC_RELAXED, __HIP_MEMORY_SCOPE_AGENT); }
DI unsigned xb_xcc_id() { return (unsigned)__builtin_amdgcn_s_getreg((3 << 11) | 20) & 0xFu; }
#define XB_SPIN(cond, bar) do { unsigned _sp = 0; while (cond) { __builtin_amdgcn_s_sleep(1); \
    if ((++_sp & 255u) == 0u) { if (xb_ld(&(bar)[XB_TMO])) break; if (_sp > XB_SPIN_CAP) { atomicAdd(&(bar)[XB_TMO], 1u); break; } } } } while (0)
DI void xcd_barrier_complete(unsigned* bar, unsigned x, unsigned G, unsigned& nloc, unsigned& nx) {
    unsigned sum, cnt, mine, sp = 0u;
    for (;;) {
        sum = 0u; cnt = 0u; mine = 0u;
#pragma unroll
        for (unsigned j = 0; j < 16; ++j) { const unsigned c = xb_ld(&bar[XB_XCNT(j)]); sum += c; cnt += (c > 0u) ? 1u : 0u; mine = (j == x) ? c : mine; }
        if (sum == G) break;
        __builtin_amdgcn_s_sleep(1);
        if ((++sp & 255u) == 0u) { if (xb_ld(&bar[XB_TMO])) break; if (sp > XB_SPIN_CAP) { atomicAdd(&bar[XB_TMO], 1u); break; } }
    }
    nloc = mine > 0u ? mine : 1u; nx = cnt > 0u ? cnt : 1u;
}
DI void grid_barrier(unsigned* bar, volatile LAS unsigned* st, unsigned G, const int tid) {
    asm volatile("s_waitcnt vmcnt(0)" ::: "memory");
    __syncthreads();
    if (tid == 0) {
        __builtin_amdgcn_s_waitcnt(0);
        const unsigned x = xb_xcc_id();
        unsigned nloc = st[0], nx = st[1];
        if (nloc == 0u) { xcd_barrier_complete(bar, x, G, nloc, nx); st[0] = nloc; st[1] = nx; }
        const unsigned old = xb_add(&bar[XB_XSUB(x)], 1u);
        const unsigned gen = old / nloc;
        if (old + 1u == (gen + 1u) * nloc) {
            __builtin_amdgcn_fence(__ATOMIC_RELEASE, "agent");
            asm volatile("s_waitcnt vmcnt(0)" ::: "memory");
            const unsigned og = xb_add(&bar[XB_TOP], 1u);
            const unsigned tg = og / nx;
            if (og + 1u == (tg + 1u) * nx) xb_add(&bar[XB_TOPGEN], 1u);
            else XB_SPIN(xb_ld(&bar[XB_TOPGEN]) == tg, bar);
            __builtin_amdgcn_fence(__ATOMIC_ACQUIRE, "agent");
            xb_add(&bar[XB_XGEN(x)], 1u);
            asm volatile("s_waitcnt vmcnt(0)" ::: "memory");
        } else {
            XB_SPIN(xb_ld(&bar[XB_XGEN(x)]) == gen, bar);
            __builtin_amdgcn_fence(__ATOMIC_ACQUIRE, "agent");
            asm volatile("s_waitcnt vmcnt(0)" ::: "memory");
        }
    }
    __syncthreads();
}

#ifndef SINGLE_LAUNCH
#define SINGLE_LAUNCH 1
#endif

struct Args { const float* in[10]; float* out; unsigned char* ws; int ph_lo, ph_hi; };

template <int MODE> __global__ void __launch_bounds__(512, 2) mega(Args a) {
    extern __shared__ __attribute__((aligned(16))) unsigned char lds_raw[];
    cg::grid_group grid = cg::this_grid();
    LAS unsigned char* lds = (LAS unsigned char*)lds_raw;
    int tidl = threadIdx.x;
#define tid tidl
#define lane (tidl & 63)
#define wave (__builtin_amdgcn_readfirstlane(tidl >> 6))
    const int G = gridDim.x, c = blockIdx.x;
    const int NGW = G * 8, NGT = G * 512;
#define gw (cl * 8 + wave)
#define gt (cl * 512 + tid)
    size_t zl = 0; int cl = c;
#define GASP __attribute__((address_space(1)))
#define ARGP ((const __attribute__((address_space(4))) unsigned long long*)__builtin_amdgcn_kernarg_segment_ptr())
#define INP(i) ((const float*)(const GASP float*)ARGP[(i) + zl])
#define wsl ((unsigned char*)(GASP unsigned char*)ARGP[11 + zl])
#define OUTP ((float*)(GASP float*)ARGP[10 + zl])
#define PHASE_BEGIN() do { if (MODE != 1) asm volatile("" : "+s"(zl), "+s"(cl), "+v"(tidl) :: "memory"); } while (0)
#define PHASE_BEGIN1() do { if (MODE != 0) asm volatile("" : "+s"(zl), "+s"(cl), "+v"(tidl) :: "memory"); } while (0)
#define XIN INP(0)
#define fox_w_in INP(1)
#define fox_b_f INP(2)
#define fox_qg INP(3)
#define fox_kg INP(4)
#define fox_w_out INP(5)
#define ret_w_in INP(6)
#define ret_w_out INP(7)
#define ln_g INP(8)
#define ln_b INP(9)
#define cosT ((float*)(wsl + WS_COS))
#define sinT ((float*)(wsl + WS_SIN))
#define cosTT ((float*)(wsl + WS_COSTT))
#define sinTT ((float*)(wsl + WS_SINTT))
#define gpow ((float*)(wsl + WS_GPOW))
#define kdec ((float*)(wsl + WS_KDEC))
#define ginv ((float*)(wsl + WS_GINV))
#define LOGIT ((float*)(wsl + WS_LOGIT))
#define AUG ((float*)(wsl + WS_AUG))
#define WFT ((bf16*)(wsl + WS_WFT))
#define WFI ((bf16*)(wsl + WS_WFI))
#define WFO ((bf16*)(wsl + WS_WFO))
#define WRI ((bf16*)(wsl + WS_WRI))
#define WRO ((bf16*)(wsl + WS_WRO))
#define HB ((bf16*)(wsl + WS_HB))
#define H32 ((float*)(wsl + WS_H32))
#define RA ((bf16*)(wsl + WS_RA))
#define RB ((bf16*)(wsl + WS_RB))
#define RK ((bf16*)(wsl + WS_RK))
#define RKT ((bf16*)(wsl + WS_RKT))
#define RG ((bf16*)(wsl + WS_RG))
#define RU ((bf16*)(wsl + WS_RU))
#define PROJ RB
#define YF RA
#define ACAT RA
#define BCAT RB
#define YR RK
#define OB RU

    const int ph_lo = a.ph_lo, ph_hi = a.ph_hi;
    if (MODE != 1) { if (tidl < 2) ((volatile LAS unsigned*)(lds + 131072 + 1024))[tidl] = 0u;
        if (tidl == 0) (void)xb_add(&((unsigned*)(wsl + WS_BAR))[XB_XCNT(xb_xcc_id())], 1u);
        __syncthreads(); }
#ifndef NO_P0
    PHASE_BEGIN();
#ifndef REP_P0
#define REP_P0 1
#endif
    if (MODE != 1 && ph_lo == 0)
    for (int rep_ = 0; rep_ < REP_P0; ++rep_)
    {
        LAS float* scr = (LAS float*)(lds + wave * 16384);
        constexpr int I_FI = 32 * 256, I_FO = 32 * 64, I_RI = 32 * 384, I_RO = 64 * 64;
        constexpr int NITEMS = 2 * (I_FI + I_FO + I_RI + I_RO);
        auto decode = [&](int it) -> TrItem {
            int r = it; TrItem t;
            if (r < 2 * I_FI) { const int l = r / I_FI; r -= l * I_FI; t.W = fox_w_in + (size_t)l * 2048 * 8208; t.ldw = 8208; t.WT = WFI + (size_t)l * 8192 * 2048; t.ldt = 2048; t.k0 = (r / 256) * 64; t.n0 = (r % 256) * 32; return t; } r -= 2 * I_FI;
            if (r < 2 * I_FO) { const int l = r / I_FO; r -= l * I_FO; t.W = fox_w_out + (size_t)l * 2048 * 2048; t.ldw = 2048; t.WT = WFO + (size_t)l * 2048 * 2048; t.ldt = 2048; t.k0 = (r / 64) * 64; t.n0 = (r % 64) * 32; return t; } r -= 2 * I_FO;
            if (r < 2 * I_RI) { const int l = r / I_RI; r -= l * I_RI; t.W = ret_w_in + (size_t)l * 2048 * 12288; t.ldw = 12288; t.WT = WRI + (size_t)l * 12288 * 2048; t.ldt = 2048; t.k0 = (r / 384) * 64; t.n0 = (r % 384) * 32; return t; } r -= 2 * I_RI;
            { const int l = r / I_RO; r -= l * I_RO; t.W = ret_w_out + (size_t)l * 4096 * 2048; t.ldw = 2048; t.WT = WRO + (size_t)l * 2048 * 4096; t.ldt = 4096; t.k0 = (r / 64) * 64; t.n0 = (r % 64) * 32; return t; }
        };
        for (int it = gw; it < NITEMS; it += 2 * NGW) {
            const bool hasB = it + NGW < NITEMS;
            const TrItem ta = decode(it); const TrItem tb = decode(hasB ? it + NGW : it);
            float va[32], vb[32];
            tr_load(ta, lane, va); if (hasB) tr_load(tb, lane, vb);
            tr_store(ta, lane, va, scr); if (hasB) tr_store(tb, lane, vb, scr);
        }
        for (int i = gt; i < 2 * 16 * 2048; i += NGT) { const int l = i >> 15, n = (i >> 11) & 15, k = i & 2047; WFT[i] = (bf16)f2bf(fox_w_in[(size_t)l * 2048 * 8208 + (size_t)k * 8208 + 8192 + n]); }
        for (int i = gt; i < NTOK * DM / 4; i += 8 * NGT) {
            f32x4 v[8];
#pragma unroll
            for (int u = 0; u < 8; ++u) v[u] = ((const f32x4*)XIN)[i + u * NGT];
#pragma unroll
            for (int u = 0; u < 8; ++u) { u32x2 o; o.x = cvt_pk_bf16(v[u][0], v[u][1]); o.y = cvt_pk_bf16(v[u][2], v[u][3]); ((u32x2*)HB)[i + u * NGT] = o; } }
        for (int i = gt; i < 4096 * 128; i += NGT) { const int pos = i >> 7, fi = i & 127;
            const float inv = powf(10000.0f, -(float)(2 * fi) / 256.0f); const float ang = (float)pos * inv;
            const float cs = cosf(ang), sn = sinf(ang);
            cosT[i] = cs; sinT[i] = sn; cosTT[(size_t)fi * 4096 + pos] = cs; sinTT[(size_t)fi * 4096 + pos] = sn; }
        for (int i = gt; i < 8 * 260; i += NGT) { const int hh = i / 260, e = i % 260; const float lg = log1pf(-exp2f(-5.0f - (float)hh));
            gpow[i] = expf((float)e * lg);
            if (e < 256) { kdec[hh * 256 + e] = expf((float)(255 - e) * lg); ginv[hh * 256 + e] = expf(-(float)(e + 1) * lg); } }
    }
#endif
    if (MODE != 1 && ph_hi < 0) grid.sync();
    if (MODE != 1 && ph_lo == 0 && ph_hi > 1) grid_barrier((unsigned*)(wsl + WS_BAR), (volatile LAS unsigned*)(lds + 131072 + 1024), (unsigned)G, tidl);
#define RUN(id) (ph_lo <= (id) && (id) < ph_hi)
#define GBAR() grid_barrier((unsigned*)(wsl + WS_BAR), (volatile LAS unsigned*)(lds + 131072 + 1024), (unsigned)G, tidl)

#ifdef EXTRA_BARS
    for (int eb_ = 0; eb_ < EXTRA_BARS; ++eb_) GBAR();
#endif
#pragma unroll 1
    for (int l = 0; l < 2; ++l) {
        const int pb = 1 + 12 * l;
        const int li = 2 * l;
#ifndef NO_F1
        PHASE_BEGIN();
#ifndef REP_F1
#define REP_F1 1
#endif
        if (MODE != 1 && RUN(pb + 0)) for (int rep_ = 0; rep_ < REP_F1; ++rep_) {
        {
            const bf16* wf = WFT + (size_t)l * 16 * 2048; const int fr = lane & 15, fq = lane >> 4;
            for (int t2 = cl; t2 < 256; t2 += G) {
                const int t = t2 * 2 + (wave >> 2), kq = wave & 3;
                f32x4 acc = {0.f, 0.f, 0.f, 0.f};
                const bf16* ap = HB + (size_t)(t * 16 + fr) * 2048 + kq * 512 + fq * 8; const bf16* wp = wf + fr * 2048 + kq * 512 + fq * 8;
#pragma unroll
                for (int k = 0; k < 512; k += 32) { const bf16x8 av = *(const bf16x8*)(ap + k); const bf16x8 wv = *(const bf16x8*)(wp + k); acc = __builtin_amdgcn_mfma_f32_16x16x32_bf16(wv, av, acc, 0, 0, 0); }
                LAS f32x4* part = (LAS f32x4*)(lds + 131072 + 2048);
                part[wave * 64 + lane] = acc;
                __syncthreads();
                if (kq == 0) { const int w0 = wave; const f32x4 sum = (part[w0 * 64 + lane] + part[(w0 + 1) * 64 + lane]) + (part[(w0 + 2) * 64 + lane] + part[(w0 + 3) * 64 + lane]);
                    { const int tok = t * 16 + fr, bb = tok >> 12, ss = tok & 4095;
#pragma unroll
                      for (int j = 0; j < 4; ++j) { const int hh = fq * 4 + j; const float z = sum[j] + fox_b_f[l * 16 + hh];
                          LOGIT[((size_t)(bb * 16 + hh)) * 4096 + ss] = fminf(z, 0.f) - log1pf(expf(-fabsf(z))); } }
                }
                __syncthreads();
            }
            pg8::Gemm g{HB, WFI + (size_t)l * 8192 * 2048, 2048, 2048, 2048}; pg8::Sched S; S.init_reg(32, 32, 2048, 2048, G, cl);
            pg8::EpiFoxIn E{PROJ, fox_qg + l * 128, fox_kg + l * 128, lds + 131072 + 2048};
            pg8::gemm_phase<pg8::EpiFoxIn>(lds, g, S, E, tidl);
        }
        }
#endif
#ifndef NO_F2
        PHASE_BEGIN();
        if (false && MODE != 1 && RUN(pb + 1)) {
        {
            if (cl < 32) {
                if (tid == 0) { unsigned* cp = (unsigned*)(wsl + WS_BAR + 49152) + l * 64; unsigned sp = 0;
                    while (__hip_atomic_load(cp, __ATOMIC_RELAXED, __HIP_MEMORY_SCOPE_AGENT) < 512u) { __builtin_amdgcn_s_sleep(2); if (++sp > (1u << 22)) break; }
                    __builtin_amdgcn_fence(__ATOMIC_ACQUIRE, "agent"); asm volatile("s_waitcnt vmcnt(0)" ::: "memory"); }
                __syncthreads();
            }
            for (int bh = cl; bh < 32; bh += G) {
                float v[8]; float run = 0.f;
                { const f32x4 a0 = *(const f32x4*)(LOGIT + (size_t)bh * 4096 + tid * 8), a1 = *(const f32x4*)(LOGIT + (size_t)bh * 4096 + tid * 8 + 4);
#pragma unroll
                  for (int e = 0; e < 4; ++e) { run += a0[e]; v[e] = run; }
#pragma unroll
                  for (int e = 0; e < 4; ++e) { run += a1[e]; v[4 + e] = run; } }
                float incl = run;
#pragma unroll
                for (int o = 1; o < 64; o <<= 1) { const float t = __shfl_up(incl, o); if (lane >= o) incl += t; }
                LAS float* wt = (LAS float*)lds;
                __syncthreads();
                if (lane == 63) wt[wave] = incl;
                __syncthreads();
                float base = incl - run;
                for (int w = 0; w < wave; ++w) base += wt[w];
                { f32x4 o0, o1;
#pragma unroll
                  for (int e = 0; e < 4; ++e) { o0[e] = -(base + v[e]) * 11.313708498984761f; o1[e] = -(base + v[4 + e]) * 11.313708498984761f; }
                  *(f32x4*)(AUG + (size_t)bh * 4096 + tid * 8) = o0; *(f32x4*)(AUG + (size_t)bh * 4096 + tid * 8 + 4) = o1; }
                __syncthreads();
            }
        }
        }
#endif
        if (RUN(pb + 1) && RUN(pb + 2)) GBAR();
#if !defined(NO_F3)
        PHASE_BEGIN1();
#ifndef REP_F3
#define REP_F3 1
#endif
        if (MODE != 0 && RUN(pb + 2)) for (int rep_ = 0; rep_ < REP_F3; ++rep_) {
        fa::attn_phase((char*)lds_raw, PROJ, LOGIT, YF, G, cl, tidl);
        }
#endif
        if (RUN(pb + 2) && RUN(pb + 3)) GBAR();
#ifndef NO_F4
        PHASE_BEGIN();
        if (MODE != 1 && RUN(pb + 3)) {
        {
            pg8::Gemm g{YF, WFO + (size_t)l * 2048 * 2048, 2048, 2048, 2048}; pg8::Sched S; S.init_reg(32, 8, 2048, 2048, G, cl);
            pg8::EpiLnFused E{l == 0 ? XIN : (RESID_BF16 ? (const float*)nullptr : H32), RESID_BF16 ? (float*)nullptr : H32, HB, ln_g + li * 2048, ln_b + li * 2048, 1.6817928305074290f,
                (unsigned long long*)(wsl + WS_XSLOT) + (size_t)(2 * l) * 65536, (unsigned*)(wsl + WS_LNCNT) + (2 * l) * 2048, lds + 131072 + 2048};
            pg8::gemm_phase<pg8::EpiLnFused>(lds, g, S, E, tidl);
        }
        }
#endif
        if (RUN(pb + 3) && RUN(pb + 4)) GBAR();
#ifndef NO_F5
        PHASE_BEGIN();
        if (false && MODE != 1 && RUN(pb + 4)) {
        {
            const float* gn = ln_g + li * 2048; const float* bt = ln_b + li * 2048;
            for (int r = gw; r < NTOK; r += NGW) {
                float* row = H32 + (size_t)r * 2048; f32x4 v[8]; float s = 0.f;
#pragma unroll
                for (int j = 0; j < 8; ++j) { v[j] = *(const f32x4*)(row + (j * 64 + lane) * 4); s += (v[j][0] + v[j][1]) + (v[j][2] + v[j][3]); }
                const float mean = wave_sum(s) * (1.f / 2048.f); float s2 = 0.f;
#pragma unroll
                for (int j = 0; j < 8; ++j) { v[j] = v[j] - mean; s2 += (v[j][0] * v[j][0] + v[j][1] * v[j][1]) + (v[j][2] * v[j][2] + v[j][3] * v[j][3]); }
                const float rstd = rsqrtf(wave_sum(s2) * (1.f / 2048.f) + 1e-5f);
#pragma unroll
                for (int j = 0; j < 8; ++j) { const int cc = (j * 64 + lane) * 4; const f32x4 y = v[j] * rstd * *(const f32x4*)(gn + cc) + *(const f32x4*)(bt + cc);
                    *(f32x4*)(row + cc) = y; u32x2 o; o.x = cvt_pk_bf16(y[0], y[1]); o.y = cvt_pk_bf16(y[2], y[3]); *(u32x2*)(HB + (size_t)r * 2048 + cc) = o; }
            }
        }
        }
#endif

        const int lj = 2 * l + 1;
#ifndef NO_R1
        PHASE_BEGIN();
#ifndef REP_R1
#define REP_R1 1
#endif
        if (MODE != 1 && RUN(pb + 5)) for (int rep_ = 0; rep_ < REP_R1; ++rep_) {
        {
            pg8::Gemm g{HB, WRI + (size_t)l * 12288 * 2048, 2048, 2048, 2048}; pg8::Sched S; S.init_reg(32, 32, 2048, 2048, G, cl, 16, 16);
            pg8::EpiRetNat E{ACAT, RK, RG, cosT, sinT, gpow, RKT, kdec};
            pg8::gemm_phase<pg8::EpiRetNat>(lds, g, S, E, tidl);
        }
        PHASE_BEGIN();
        {
            pg8::Gemm g{WRI + (size_t)l * 12288 * 2048 + (size_t)4096 * 2048, HB, 2048, 2048, 2048}; pg8::Sched S; S.init_reg(16, 32, 2048, 2048, G, cl);
            pg8::EpiRetSwap E{BCAT};
            pg8::gemm_phase<pg8::EpiRetSwap>(lds, g, S, E, tidl);
        }
        }
#endif
        if (RUN(pb + 5) && RUN(pb + 6)) GBAR();
#ifndef NO_R2
        PHASE_BEGIN();
#ifndef REP_R2
#define REP_R2 1
#endif
        if (MODE != 1 && RUN(pb + 6)) for (int rep_ = 0; rep_ < REP_R2; ++rep_) {
        {
            pg8::Gemm g{BCAT, RKT, 512, 256, 256}; pg8::Sched S; S.init_bat(256, 2, 512u * 512u * 2u, 256u * 512u * 2u, 256u * 256u * 2u, 0u, G, cl);
            pg8::EpiU E{RU};
            pg8::gemm_phase<pg8::EpiU, true, false>(lds, g, S, E, tidl);
        }
#ifndef NO_R2B
        PHASE_BEGIN();
        {
            pg8::Gemm g{ACAT + 256, RK, 512, 256, 256}; pg8::Sched S; S.init_bat(256, 1, 256u * 512u * 2u, 0u, 256u * 256u * 2u, 0u, G, cl);
            pg8::EpiT E{ACAT, ginv};
            pg8::gemm_phase<pg8::EpiT, true, false>(lds, g, S, E, tidl);
        }
#endif
        }
#endif
        if (RUN(pb + 6) && RUN(pb + 7)) GBAR();
#ifndef NO_R3
        PHASE_BEGIN();
#ifndef REP_R3
#define REP_R3 1
#endif
        if (MODE != 1 && RUN(pb + 7)) for (int rep_ = 0; rep_ < REP_R3; ++rep_) {
        for (int gi = gt; gi < 16 * 16384; gi += NGT) {
            const int bh = gi >> 14, idx = gi & 16383, v = idx >> 5, d8 = (idx & 31) * 8, hh = bh & 7; const float cd = gpow[hh * 260 + 256];
            float R[8] = {0.f, 0.f, 0.f, 0.f, 0.f, 0.f, 0.f, 0.f};
            u32x4 un[15];
#pragma unroll
            for (int n = 0; n < 15; ++n) un[n] = *(const u32x4*)(RU + ((size_t)(bh * 16 + n) * 512 + v) * 256 + d8);
#pragma unroll
            for (int n = 0; n < 16; ++n) {
                u32x4 o; o.x = cvt_pk_bf16(R[0], R[1]); o.y = cvt_pk_bf16(R[2], R[3]); o.z = cvt_pk_bf16(R[4], R[5]); o.w = cvt_pk_bf16(R[6], R[7]);
                *(u32x4*)(BCAT + ((size_t)(bh * 16 + n) * 512 + v) * 512 + 256 + d8) = o;
                if (n < 15) { const u32x4 u = un[n];
                    R[0] = cd * R[0] + bf_lo(u.x); R[1] = cd * R[1] + bf_hi(u.x); R[2] = cd * R[2] + bf_lo(u.y); R[3] = cd * R[3] + bf_hi(u.y);
                    R[4] = cd * R[4] + bf_lo(u.z); R[5] = cd * R[5] + bf_hi(u.z); R[6] = cd * R[6] + bf_lo(u.w); R[7] = cd * R[7] + bf_hi(u.w); }
            }
        }
        }
#endif
        if (RUN(pb + 7) && RUN(pb + 8)) GBAR();
#ifndef NO_R4
        PHASE_BEGIN();
#ifndef REP_R4
#define REP_R4 1
#endif
        if (MODE != 1 && RUN(pb + 8)) for (int rep_ = 0; rep_ < REP_R4; ++rep_) {
        {
            pg8::Gemm g{ACAT, BCAT, 512, 512, 512}; pg8::Sched S; S.init_bat(256, 2, 256u * 512u * 2u, 0u, 512u * 512u * 2u, 256u * 512u * 2u, G, cl);
            pg8::EpiOGn E{YR, RG, (unsigned long long*)(wsl + WS_GSLOT), (unsigned*)(wsl + WS_GNCNT) + l * 256 * 64, lds + 131072 + 2048};
            pg8::gemm_phase<pg8::EpiOGn, true, false>(lds, g, S, E, tidl);
        }
        }
#endif
        if (RUN(pb + 8) && RUN(pb + 9)) GBAR();
#ifndef NO_R5
        PHASE_BEGIN();
#ifndef REP_R5
#define REP_R5 1
#endif
        if (false && MODE != 1 && RUN(pb + 9)) for (int rep_ = 0; rep_ < REP_R5; ++rep_) {
        for (int t = gw; t < NTOK; t += NGW) {
#pragma unroll 2
            for (int hh = 0; hh < 8; ++hh) {
                const size_t off = (size_t)t * 4096 + hh * 512 + lane * 8;
                const u32x4 raw = *(const u32x4*)(OB + off); const u32x4 gr = *(const u32x4*)(RG + off);
                float v[8] = {bf_lo(raw.x), bf_hi(raw.x), bf_lo(raw.y), bf_hi(raw.y), bf_lo(raw.z), bf_hi(raw.z), bf_lo(raw.w), bf_hi(raw.w)};
                float gv[8] = {bf_lo(gr.x), bf_hi(gr.x), bf_lo(gr.y), bf_hi(gr.y), bf_lo(gr.z), bf_hi(gr.z), bf_lo(gr.w), bf_hi(gr.w)};
                float s = 0.f;
#pragma unroll
                for (int e = 0; e < 8; ++e) s += v[e];
                const float mean = wave_sum(s) * (1.f / 512.f); float s2 = 0.f;
#pragma unroll
                for (int e = 0; e < 8; ++e) { v[e] -= mean; s2 += v[e] * v[e]; }
                const float rstd = rsqrtf(wave_sum(s2) * (1.f / 512.f) + 1e-6f);
                float y[8];
#pragma unroll
                for (int e = 0; e < 8; ++e) y[e] = v[e] * rstd * gv[e] / (1.f + __expf(-gv[e]));
                u32x4 o; o.x = cvt_pk_bf16(y[0], y[1]); o.y = cvt_pk_bf16(y[2], y[3]); o.z = cvt_pk_bf16(y[4], y[5]); o.w = cvt_pk_bf16(y[6], y[7]);
                *(u32x4*)(YR + off) = o;
            }
        }
        }
#endif
#ifndef NO_R6
        PHASE_BEGIN();
        if (MODE != 1 && RUN(pb + 10)) {
        {
            pg8::Gemm g{YR, WRO + (size_t)l * 2048 * 4096, 4096, 4096, 4096}; pg8::Sched S; S.init_reg(32, 8, 4096, 4096, G, cl);
            pg8::EpiLnFused E{RESID_BF16 ? (const float*)nullptr : H32, (l == 1) ? OUTP : (RESID_BF16 ? (float*)nullptr : H32), HB, ln_g + lj * 2048, ln_b + lj * 2048, 1.6817928305074290f,
                (unsigned long long*)(wsl + WS_XSLOT) + (size_t)(2 * l + 1) * 65536, (unsigned*)(wsl + WS_LNCNT) + (2 * l + 1) * 2048, lds + 131072 + 2048};
            pg8::gemm_phase<pg8::EpiLnFused>(lds, g, S, E, tidl);
        }
        }
#endif
        if (l == 0 && RUN(pb + 10) && RUN(pb + 11)) GBAR();
#ifndef NO_R7
        PHASE_BEGIN();
        if (false && MODE != 1 && RUN(pb + 11)) {
        {
            const float* gn = ln_g + lj * 2048; const float* bt = ln_b + lj * 2048; float* dstf = (l == 1) ? OUTP : H32;
            for (int r = gw; r < NTOK; r += NGW) {
                const float* row = H32 + (size_t)r * 2048; f32x4 v[8]; float s = 0.f;
#pragma unroll
                for (int j = 0; j < 8; ++j) { v[j] = *(const f32x4*)(row + (j * 64 + lane) * 4); s += (v[j][0] + v[j][1]) + (v[j][2] + v[j][3]); }
                const float mean = wave_sum(s) * (1.f / 2048.f); float s2 = 0.f;
#pragma unroll
                for (int j = 0; j < 8; ++j) { v[j] = v[j] - mean; s2 += (v[j][0] * v[j][0] + v[j][1] * v[j][1]) + (v[j][2] * v[j][2] + v[j][3] * v[j][3]); }
                const float rstd = rsqrtf(wave_sum(s2) * (1.f / 2048.f) + 1e-5f);
#pragma unroll
                for (int j = 0; j < 8; ++j) { const int cc = (j * 64 + lane) * 4; const f32x4 y = v[j] * rstd * *(const f32x4*)(gn + cc) + *(const f32x4*)(bt + cc);
                    *(f32x4*)(dstf + (size_t)r * 2048 + cc) = y; u32x2 o; o.x = cvt_pk_bf16(y[0], y[1]); o.y = cvt_pk_bf16(y[2], y[3]); *(u32x2*)(HB + (size_t)r * 2048 + cc) = o; }
            }
        }
        }
#endif
    }
}


extern "C" void kernel_launch(void* const* d_in, const int* in_sizes, int n_in, void* d_out, int out_size, void* d_ws, size_t ws_size, hipStream_t stream) {
    static int grid = 0;
    if (grid == 0) {
        if (n_in != 10 || ws_size < WS_END) { fprintf(stderr, "kernel_launch: unexpected n_in %d / ws_size %zu (need %zu)\n", n_in, ws_size, (size_t)WS_END); grid = -1; return; }
        int dev = 0, cus = 0, per_cu = 0;
        hipGetDevice(&dev); hipDeviceGetAttribute(&cus, hipDeviceAttributeMultiprocessorCount, dev);
#if SINGLE_LAUNCH
        hipFuncSetAttribute((const void*)mega<2>, hipFuncAttributeMaxDynamicSharedMemorySize, LDS_BYTES);
#else
        hipFuncSetAttribute((const void*)mega<0>, hipFuncAttributeMaxDynamicSharedMemorySize, LDS_BYTES);
        hipFuncSetAttribute((const void*)mega<1>, hipFuncAttributeMaxDynamicSharedMemorySize, LDS_BYTES);
#endif
        hipOccupancyMaxActiveBlocksPerMultiprocessor(&per_cu, (const void*)mega<SINGLE_LAUNCH ? 2 : 0>, 512, LDS_BYTES);
        if (per_cu < 1) { fprintf(stderr, "kernel_launch: occupancy query says %d blocks per CU\n", per_cu); per_cu = 1; }
        grid = cus;
    }
    if (grid < 0) return;
    Args a{};
    for (int i = 0; i < 10; ++i) a.in[i] = (const float*)d_in[i];
    a.out = (float*)d_out; a.ws = (unsigned char*)d_ws;
#if SINGLE_LAUNCH
    const int cuts[2] = {0, 25}; const int nl = 1;
#else
    const int cuts[4] = {0, 3, 15, 25}; const int nl = 3;
#endif
    for (int li = 0; li < nl; ++li) {
        if (hipMemsetAsync((char*)d_ws + WS_BAR, 0, 65536 + 2 * 256 * 256, stream) != hipSuccess) { fprintf(stderr, "memset failed\n"); return; }
        a.ph_lo = cuts[li] + (li > 0 ? 1 : 0); a.ph_hi = cuts[li + 1];
        void* args[] = {&a};
#if SINGLE_LAUNCH
        hipError_t e = hipLaunchCooperativeKernel((const void*)mega<2>, dim3(grid), dim3(512), args, LDS_BYTES, stream);
#else
        hipError_t e = hipLaunchCooperativeKernel((const void*)mega<0>, dim3(grid), dim3(512), args, LDS_BYTES, stream);
#endif
        if (e != hipSuccess) { fprintf(stderr, "cooperative launch failed: %s (grid %d)\n", hipGetErrorString(e), grid); return; }
#if !SINGLE_LAUNCH
        if (li + 1 < nl) { Args b = a; b.ph_lo = cuts[li + 1]; b.ph_hi = cuts[li + 1] + 1; hipLaunchKernelGGL(mega<1>, dim3(grid), dim3(512), LDS_BYTES, stream, b); }
#endif
    }
}
```
